# Optimizing an MI355X kernel written in HIP

```python
import math
import jax, jax.numpy as jnp
from jax import lax
import numpy as np

D_MODEL = 1024
BATCH = 16
SEQ = 256
DEPTH = 2
DEC_BATCH = 2
DEC_SEQ = 4096
PAST_LEN = 512

GRID_W = 64
HEAD_DIM = 64
GQA_HEADS = 8
GQA_KV_HEADS = 2
GQA_GROUP = GQA_HEADS // GQA_KV_HEADS
GLA_HEADS = 4
GLA_DK = 64
GLA_DV = 128
GLA_RANK = 16
GLA_TAU = 16.0
GLA_CHUNK = 64
DIFF_HEADS = 4
DIFF_DV = 2 * HEAD_DIM
N_BRANCH = 3
BRANCH_W = 512
FFN_HIDDEN = ((8 * D_MODEL + 3 * 256 - 1) // (3 * 256)) * 256
ROPE_THETA = 10000.0
Q_BLOCK = 128
EPS = 1e-6
SPLIT_SIZES = (
    GQA_HEADS * HEAD_DIM, GQA_KV_HEADS * HEAD_DIM, GQA_KV_HEADS * HEAD_DIM,
    GLA_HEADS * GLA_DK, GLA_HEADS * GLA_DK, GLA_HEADS * GLA_DV, 2 * GLA_RANK, GLA_HEADS * GLA_DV,
    DIFF_HEADS * 2 * HEAD_DIM, DIFF_HEADS * 2 * HEAD_DIM, DIFF_HEADS * DIFF_DV,
    N_BRANCH * D_MODEL,
)
N_IN = sum(SPLIT_SIZES)

kernel_name = 'hybrid_diffusion_gqa_gla_diffattn_step'


def rms_norm(x, g):
    x32 = x.astype(jnp.float32)
    y = x32 * lax.rsqrt(jnp.mean(x32 * x32, axis=-1, keepdims=True) + EPS)
    return (y * g.astype(jnp.float32)).astype(x.dtype)


def split_columns(z):
    points, acc = [], 0
    for s in SPLIT_SIZES[:-1]:
        acc += s
        points.append(acc)
    return jnp.split(z, points, axis=-1)


def axial_rope_angles(n_tokens):
    n_rows = n_tokens // GRID_W
    row = jnp.repeat(jnp.arange(n_rows, dtype=jnp.float32), GRID_W)
    col = jnp.tile(jnp.arange(GRID_W, dtype=jnp.float32), n_rows)
    n_freq = HEAD_DIM // 4
    freqs = ROPE_THETA ** (-jnp.arange(n_freq, dtype=jnp.float32) / n_freq)
    return row[:, None] * freqs, col[:, None] * freqs


def rope_half(x, ang):
    ang = ang.reshape((1, ang.shape[0]) + (1,) * (x.ndim - 3) + (ang.shape[-1],))
    cos, sin = jnp.cos(ang), jnp.sin(ang)
    x1, x2 = jnp.split(x, 2, axis=-1)
    return jnp.concatenate([x1 * cos - x2 * sin, x2 * cos + x1 * sin], axis=-1)


def apply_axial_rope(x, angles):
    ang_row, ang_col = angles
    x32 = x.astype(jnp.float32)
    half = HEAD_DIM // 2
    out = jnp.concatenate([rope_half(x32[..., :half], ang_row), rope_half(x32[..., half:], ang_col)], axis=-1)
    return out.astype(x.dtype)


def sweep_query_blocks(fn, q):
    b, n = q.shape[:2]
    nb = n // Q_BLOCK
    blocks = jnp.moveaxis(q.reshape((b, nb, Q_BLOCK) + q.shape[2:]), 1, 0)
    out = lax.map(fn, blocks)
    return jnp.moveaxis(out, 0, 1).reshape((b, n) + out.shape[3:])


def gqa_block(q, k, v):
    s = jnp.einsum('bqkgd,bskd->bkgqs', q, k).astype(jnp.float32) * (HEAD_DIM ** -0.5)
    p = jax.nn.softmax(s, axis=-1).astype(v.dtype)
    return jnp.einsum('bkgqs,bskd->bqkgd', p, v)


def diff_block(q, k, v, lam):
    s = jnp.einsum('bqhmd,bshmd->bhmqs', q, k).astype(jnp.float32) * (HEAD_DIM ** -0.5)
    p = jax.nn.softmax(s, axis=-1)
    p = p[:, :, 0] - lam * p[:, :, 1]
    return jnp.einsum('bhqs,bshe->bqhe', p.astype(v.dtype), v)


def gla_chunked(q, k, v, log_a, s0):
    b, n, h, dk = q.shape
    dv = v.shape[-1]
    nc = n // GLA_CHUNK
    f32 = jnp.float32
    q = q.astype(f32).reshape(b, nc, GLA_CHUNK, h, dk)
    k = k.astype(f32).reshape(b, nc, GLA_CHUNK, h, dk)
    v = v.astype(f32).reshape(b, nc, GLA_CHUNK, h, dv)
    cum = jnp.cumsum(log_a.astype(f32).reshape(b, nc, GLA_CHUNK, h, dk), axis=2)
    last = cum[:, :, -1]
    q_dec = q * jnp.exp(cum)
    k_inv = k * jnp.exp(-cum)
    k_to_end = k * jnp.exp(last[:, :, None] - cum)
    mask = jnp.tril(jnp.ones((GLA_CHUNK, GLA_CHUNK), dtype=bool))
    a = jnp.where(mask, jnp.einsum('bcihd,bcjhd->bchij', q_dec, k_inv), 0.0)
    o_intra = jnp.einsum('bchij,bcjhe->bcihe', a, v)
    ds = jnp.einsum('bcjhd,bcjhe->bchde', k_to_end, v)

    def step(s, inp):
        decay, d = inp
        return decay[..., None] * s + d, s

    s_final, s_prev = lax.scan(step, s0.astype(f32), (jnp.moveaxis(jnp.exp(last), 1, 0), jnp.moveaxis(ds, 1, 0)))
    s_prev = jnp.moveaxis(s_prev, 0, 1)
    o_inter = jnp.einsum('bcihd,bchde->bcihe', q_dec, s_prev)
    return (o_intra + o_inter).reshape(b, n, h, dv), s_final


def gla_bidirectional(q, k, v, log_a, s0):
    o_f, s_f = gla_chunked(q, k, v, log_a[:, :, 0], s0[:, 0])
    flip = lambda t: jnp.flip(t, axis=1)
    o_b, s_b = gla_chunked(flip(q), flip(k), flip(v), flip(log_a[:, :, 1]), s0[:, 1])
    return o_f + flip(o_b), jnp.stack([s_f, s_b], axis=1)


def token_mixers(h, p, l, angles, ctx):
    b, n = h.shape[:2]
    (gq, gk, gv, lq, lk, lv, lr, lgo, dq, dk, dv, merge) = split_columns(h @ p['w_in'][l])
    gq = rms_norm(gq.reshape(b, n, GQA_HEADS, HEAD_DIM), p['gqa_q_norm'][l])
    gk = rms_norm(gk.reshape(b, n, GQA_KV_HEADS, HEAD_DIM), p['gqa_k_norm'][l])
    gv = gv.reshape(b, n, GQA_KV_HEADS, HEAD_DIM)
    dq = rms_norm(dq.reshape(b, n, DIFF_HEADS, 2, HEAD_DIM), p['diff_q_norm'][l])
    dk = rms_norm(dk.reshape(b, n, DIFF_HEADS, 2, HEAD_DIM), p['diff_k_norm'][l])
    dv = dv.reshape(b, n, DIFF_HEADS, DIFF_DV)
    if angles is not None:
        gq, gk = apply_axial_rope(gq, angles), apply_axial_rope(gk, angles)
        dq, dk = apply_axial_rope(dq, angles), apply_axial_rope(dk, angles)
    if ctx is None:
        gk_all, gv_all, dk_all, dv_all = gk, gv, dk, dv
        s0 = jnp.zeros((b, 2, GLA_HEADS, GLA_DK, GLA_DV), jnp.float32)
    else:
        c_gk, c_gv, c_state, c_dk, c_dv = ctx
        gk_all = jnp.concatenate([gk, c_gk.astype(gk.dtype)], axis=1)
        gv_all = jnp.concatenate([gv, c_gv.astype(gv.dtype)], axis=1)
        dk_all = jnp.concatenate([dk, c_dk.astype(dk.dtype)], axis=1)
        dv_all = jnp.concatenate([dv, c_dv.astype(dv.dtype)], axis=1)
        s0 = c_state
    gqa_out = sweep_query_blocks(lambda qb: gqa_block(qb, gk_all, gv_all),
                                 gq.reshape(b, n, GQA_KV_HEADS, GQA_GROUP, HEAD_DIM)).reshape(b, n, BRANCH_W)
    lq = lq.reshape(b, n, GLA_HEADS, GLA_DK) * (GLA_DK ** -0.5)
    lk = lk.reshape(b, n, GLA_HEADS, GLA_DK)
    lv = lv.reshape(b, n, GLA_HEADS, GLA_DV)
    z = jnp.einsum('bnzr,zrf->bnzf', lr.reshape(b, n, 2, GLA_RANK), p['gla_alpha_up'][l]) + p['gla_alpha_bias'][l]
    log_a = (jax.nn.log_sigmoid(z.astype(jnp.float32)) / GLA_TAU).reshape(b, n, 2, GLA_HEADS, GLA_DK)
    o_gla, s_new = gla_bidirectional(lq, lk, lv, log_a, s0)
    gla_out = rms_norm(o_gla.astype(h.dtype), p['gla_out_norm'][l]) * jax.nn.silu(lgo.reshape(b, n, GLA_HEADS, GLA_DV))
    gla_out = gla_out.reshape(b, n, BRANCH_W)
    lam_init = 0.8 - 0.6 * math.exp(-0.3 * l)
    lp = p['diff_lambda'][l].astype(jnp.float32)
    lam = jnp.exp(jnp.sum(lp[0] * lp[1])) - jnp.exp(jnp.sum(lp[2] * lp[3])) + lam_init
    d_out = sweep_query_blocks(lambda qb: diff_block(qb, dk_all, dv_all, lam), dq)
    diff_out = (rms_norm(d_out, p['diff_sub_norm'][l]) * (1.0 - lam_init)).reshape(b, n, BRANCH_W)
    outs = jnp.stack([gqa_out, gla_out, diff_out], axis=2)
    y = jnp.einsum('bnie,ied->bnid', outs, p['w_branch'][l])
    gates = jax.nn.sigmoid(merge.reshape(b, n, N_BRANCH, D_MODEL))
    mixed = jnp.sum(gates * y, axis=2) @ p['w_out'][l]
    return mixed, (gk, gv, s_new.astype(h.dtype), dk, dv)


def layer(x, cond, p, l, angles, ctx):
    mod = jax.nn.silu(cond) @ p['w_mod'][l] + p['b_mod'][l]
    sh1, sc1, g1, sh2, sc2, g2 = jnp.split(mod, 6, axis=-1)
    h = rms_norm(x, p['norm1'][l]) * (1.0 + sc1) + sh1
    mixed, ctx_out = token_mixers(h, p, l, angles, ctx)
    x = x + g1 * mixed
    h = rms_norm(x, p['norm2'][l]) * (1.0 + sc2) + sh2
    a, u = jnp.split(h @ p['w_ffn_in'][l], 2, axis=-1)
    x = x + g2 * ((jax.nn.silu(a) * u) @ p['w_ffn_out'][l])
    return x, ctx_out


def setup_inputs(seed: int = 0) -> dict:
    key = jax.random.key(seed)
    ks = jax.random.split(key, 32)
    nrm = lambda k, shape, s=1.0: jax.random.normal(k, shape, jnp.float32) * s
    gain = lambda k, shape: 1.0 + 0.02 * jax.random.normal(k, shape, jnp.float32)
    return {
        'x_prompt': nrm(ks[0], (BATCH, SEQ, D_MODEL)),
        'x_sample': nrm(ks[1], (DEC_BATCH, DEC_SEQ, D_MODEL)),
        'c': nrm(ks[2], (DEC_BATCH, D_MODEL)),
        'cache_gqa_k': nrm(ks[3], (DEC_BATCH, DEPTH, PAST_LEN, GQA_KV_HEADS, HEAD_DIM)),
        'cache_gqa_v': nrm(ks[4], (DEC_BATCH, DEPTH, PAST_LEN, GQA_KV_HEADS, HEAD_DIM)),
        'state_gla': nrm(ks[5], (DEC_BATCH, DEPTH, 2, GLA_HEADS, GLA_DK, GLA_DV)),
        'cache_diff_k': nrm(ks[6], (DEC_BATCH, DEPTH, PAST_LEN, DIFF_HEADS, 2, HEAD_DIM)),
        'cache_diff_v': nrm(ks[7], (DEC_BATCH, DEPTH, PAST_LEN, DIFF_HEADS, DIFF_DV)),
        'c_ctx': nrm(ks[8], (D_MODEL,)),
        'w_mod': nrm(ks[9], (DEPTH, D_MODEL, 6 * D_MODEL), 0.5 * D_MODEL ** -0.5),
        'b_mod': nrm(ks[10], (DEPTH, 6 * D_MODEL), 0.01),
        'norm1': gain(ks[11], (DEPTH, D_MODEL)),
        'norm2': gain(ks[12], (DEPTH, D_MODEL)),
        'w_in': nrm(ks[13], (DEPTH, D_MODEL, N_IN), D_MODEL ** -0.5),
        'gqa_q_norm': gain(ks[14], (DEPTH, HEAD_DIM)),
        'gqa_k_norm': gain(ks[15], (DEPTH, HEAD_DIM)),
        'gla_alpha_up': nrm(ks[16], (DEPTH, 2, GLA_RANK, GLA_HEADS * GLA_DK), GLA_RANK ** -0.5),
        'gla_alpha_bias': nrm(ks[17], (DEPTH, 2, GLA_HEADS * GLA_DK), 0.1),
        'gla_out_norm': gain(ks[18], (DEPTH, GLA_DV)),
        'diff_q_norm': gain(ks[19], (DEPTH, HEAD_DIM)),
        'diff_k_norm': gain(ks[20], (DEPTH, HEAD_DIM)),
        'diff_lambda': nrm(ks[21], (DEPTH, 4, HEAD_DIM), 0.1),
        'diff_sub_norm': gain(ks[22], (DEPTH, DIFF_DV)),
        'w_branch': nrm(ks[23], (DEPTH, N_BRANCH, BRANCH_W, D_MODEL), BRANCH_W ** -0.5),
        'w_out': nrm(ks[24], (DEPTH, D_MODEL, D_MODEL), D_MODEL ** -0.5),
        'w_ffn_in': nrm(ks[25], (DEPTH, D_MODEL, 2 * FFN_HIDDEN), D_MODEL ** -0.5),
        'w_ffn_out': nrm(ks[26], (DEPTH, FFN_HIDDEN, D_MODEL), FFN_HIDDEN ** -0.5),
    }


def reference(x_prompt, x_sample, c, cache_gqa_k, cache_gqa_v, state_gla, cache_diff_k, cache_diff_v,
              c_ctx, w_mod, b_mod, norm1, norm2, w_in, gqa_q_norm, gqa_k_norm, gla_alpha_up, gla_alpha_bias,
              gla_out_norm, diff_q_norm, diff_k_norm, diff_lambda, diff_sub_norm, w_branch, w_out,
              w_ffn_in, w_ffn_out):
    p = {
        'w_mod': w_mod, 'b_mod': b_mod, 'norm1': norm1, 'norm2': norm2, 'w_in': w_in,
        'gqa_q_norm': gqa_q_norm, 'gqa_k_norm': gqa_k_norm, 'gla_alpha_up': gla_alpha_up,
        'gla_alpha_bias': gla_alpha_bias, 'gla_out_norm': gla_out_norm, 'diff_q_norm': diff_q_norm,
        'diff_k_norm': diff_k_norm, 'diff_lambda': diff_lambda, 'diff_sub_norm': diff_sub_norm,
        'w_branch': w_branch, 'w_out': w_out, 'w_ffn_in': w_ffn_in, 'w_ffn_out': w_ffn_out,
    }
    y_prompt = x_prompt
    cond_ctx = c_ctx[None, None, :]
    ctx_tensors = []
    for l in range(DEPTH):
        y_prompt, ctx_t = layer(y_prompt, cond_ctx, p, l, None, None)
        ctx_tensors.append(ctx_t)
    new_gqa_k = jnp.stack([t[0] for t in ctx_tensors], axis=1)
    new_gqa_v = jnp.stack([t[1] for t in ctx_tensors], axis=1)
    new_state_gla = jnp.stack([t[2] for t in ctx_tensors], axis=1)
    new_diff_k = jnp.stack([t[3] for t in ctx_tensors], axis=1)
    new_diff_v = jnp.stack([t[4] for t in ctx_tensors], axis=1)
    angles = axial_rope_angles(x_sample.shape[1])
    y_sample = x_sample
    cond_lat = c[:, None, :]
    for l in range(DEPTH):
        ctx = (cache_gqa_k[:, l], cache_gqa_v[:, l], state_gla[:, l], cache_diff_k[:, l], cache_diff_v[:, l])
        y_sample, _ = layer(y_sample, cond_lat, p, l, angles, ctx)
    return (y_prompt, y_sample, new_gqa_k, new_gqa_v, new_state_gla, new_diff_k, new_diff_v)
```

```cpp
#define ONE_LAUNCH 1
#include <hip/hip_runtime.h>
#include <hip/hip_cooperative_groups.h>
#include <cstdio>
#include <cstdint>
namespace cg = cooperative_groups;

#define DEV __device__ __forceinline__
typedef unsigned short u16;
typedef short bf16x8 __attribute__((ext_vector_type(8)));
typedef float f32x4 __attribute__((ext_vector_type(4)));
typedef unsigned u32x4 __attribute__((ext_vector_type(4)));
typedef unsigned u32x2 __attribute__((ext_vector_type(2)));
#define LAS __attribute__((address_space(3)))

constexpr int NTOK = 12288;
constexpr int DM = 1024;
constexpr int NIN_SRC = 6944;
constexpr int NWIN = 7040;
constexpr int FFH = 2816;
constexpr float EPSV = 1e-6f;
constexpr float QSCALE = 0.125f * 1.4426950408889634f;

constexpr size_t al256(size_t x) { return (x + 255) & ~(size_t)255; }
constexpr size_t OFF_WIN = 0;
constexpr size_t OFF_WBR = OFF_WIN + al256((size_t)NWIN * 1024 * 2);
constexpr size_t OFF_WOUT = OFF_WBR + al256((size_t)3 * 1024 * 512 * 2);
constexpr size_t OFF_WFI = OFF_WOUT + al256((size_t)1024 * 1024 * 2);
constexpr size_t OFF_WFO = OFF_WFI + al256((size_t)5632 * 1024 * 2);
constexpr size_t OFF_MOD = OFF_WFO + al256((size_t)1024 * 2816 * 2);
constexpr size_t OFF_ROPE = OFF_MOD + al256((size_t)2 * 3 * 6144 * 4);
constexpr size_t OFF_H = OFF_ROPE + al256((size_t)64 * 16 * 2 * 4);
constexpr size_t OFF_QG = OFF_H + al256((size_t)NTOK * 1024 * 2);
constexpr size_t OFF_QD = OFF_QG + al256((size_t)NTOK * 512 * 2);
constexpr size_t OFF_KGC = OFF_QD + al256((size_t)NTOK * 512 * 2);
constexpr size_t OFF_VGC = OFF_KGC + al256((size_t)16 * 2 * 256 * 64 * 2);
constexpr size_t OFF_KDC = OFF_VGC + al256((size_t)16 * 2 * 256 * 64 * 2);
constexpr size_t OFF_VDC = OFF_KDC + al256((size_t)16 * 8 * 256 * 64 * 2);
constexpr size_t OFF_KGL = OFF_VDC + al256((size_t)16 * 4 * 128 * 256 * 2);
constexpr size_t OFF_VGL = OFF_KGL + al256((size_t)2 * 2 * 4608 * 64 * 2);
constexpr size_t OFF_KDL = OFF_VGL + al256((size_t)2 * 2 * 4608 * 64 * 2);
constexpr size_t OFF_VDL = OFF_KDL + al256((size_t)2 * 8 * 4608 * 64 * 2);
constexpr size_t OFF_LQ = OFF_VDL + al256((size_t)2 * 4 * 128 * 4608 * 2);
constexpr size_t OFF_LK = OFF_LQ + al256((size_t)NTOK * 256 * 2);
constexpr size_t OFF_LVT = OFF_LK + al256((size_t)NTOK * 256 * 2);
constexpr size_t OFF_LGO = OFF_LVT + al256((size_t)NTOK * 512 * 2);
constexpr size_t OFF_LR = OFF_LGO + al256((size_t)NTOK * 512 * 2);
constexpr size_t OFF_DIFFO = OFF_LR + al256((size_t)NTOK * 32 * 4);
constexpr size_t OFF_QDG = OFF_DIFFO + al256((size_t)NTOK * 1024 * 2);
constexpr size_t OFF_OI = OFF_QDG + al256((size_t)2 * NTOK * 256 * 2);
constexpr size_t OFF_DST = OFF_OI + al256((size_t)768 * 4 * 8 * 64 * 8);
constexpr size_t OFF_DECAY = OFF_DST + al256((size_t)1536 * 8192 * 2);
constexpr size_t OFF_BAR = OFF_DECAY + al256((size_t)1536 * 64 * 4);
constexpr size_t OFF_CNT = OFF_BAR + al256((size_t)3456 * 4);
constexpr size_t WS_END = OFF_CNT + al256((size_t)3 * 128 * 4);
constexpr size_t OFF_SPREV = OFF_KGC;
constexpr size_t OFF_MIXED = OFF_KGC;
constexpr size_t OFF_GLAOUT = OFF_LQ;
constexpr size_t OFF_DIFFOUT = OFF_LVT;
constexpr size_t OFF_ACT = OFF_DIFFO;
static_assert(OFF_LQ - OFF_KGC >= (size_t)NTOK * 1024 * 2, "alias");
static_assert(OFF_DECAY - OFF_DIFFO >= (size_t)NTOK * 2816 * 2, "alias");
static_assert(WS_END <= (size_t)256 * 1024 * 1024, "ws");

constexpr size_t OUT_GK = 12582912, OUT_GV = 13631488, OUT_ST = 14680064, OUT_DK = 16777216, OUT_DV = 20971520;

struct Params {
    const float *x_prompt, *x_sample, *c, *cache_gqa_k, *cache_gqa_v, *state_gla, *cache_diff_k, *cache_diff_v, *c_ctx,
        *w_mod, *b_mod, *norm1, *norm2, *w_in, *gqa_q_norm, *gqa_k_norm, *gla_alpha_up, *gla_alpha_bias, *gla_out_norm,
        *diff_q_norm, *diff_k_norm, *diff_lambda, *diff_sub_norm, *w_branch, *w_out, *w_ffn_in, *w_ffn_out;
    float* out;
    char* ws;
    int phase_lo, phase_hi, pad0, pad1;
};

typedef __bf16 bf16x2_t __attribute__((ext_vector_type(2)));
typedef float f32x2_t __attribute__((ext_vector_type(2)));
DEV u16 f2bf(float f) { const __bf16 b = (__bf16)f; return __builtin_bit_cast(u16, b); }
DEV float bf2f(u16 h) { return __uint_as_float(((unsigned)h) << 16); }
DEV unsigned pack2(float lo, float hi) { const f32x2_t v = {lo, hi}; const bf16x2_t b = __builtin_convertvector(v, bf16x2_t); return __builtin_bit_cast(unsigned, b); }
DEV float sigmoidf_(float x) { return 1.0f / (1.0f + __expf(-x)); }
DEV float siluf_(float x) { return x / (1.0f + __expf(-x)); }
DEV int tok_cond(int t) { return t < 4096 ? 0 : 1 + ((t - 4096) >> 12); }
DEV int tok_bs(int t) { return t < 4096 ? (t >> 8) : 16 + ((t - 4096) >> 12); }
DEV int tok_n(int t) { return t < 4096 ? (t & 255) : ((t - 4096) & 4095); }
DEV f32x4 mfma16(bf16x8 a, bf16x8 b, f32x4 c) { return __builtin_amdgcn_mfma_f32_16x16x32_bf16(a, b, c, 0, 0, 0); }

DEV u16* kg_ptr(char* ws, int bs, int kv) { return bs < 16 ? (u16*)(ws + OFF_KGC) + (size_t)((bs * 2 + kv) * 256) * 64 : (u16*)(ws + OFF_KGL) + (size_t)(((bs - 16) * 2 + kv) * 4608) * 64; }
DEV u16* vgt_ptr(char* ws, int bs, int kv) { return bs < 16 ? (u16*)(ws + OFF_VGC) + (size_t)((bs * 2 + kv) * 64) * 256 : (u16*)(ws + OFF_VGL) + (size_t)(((bs - 16) * 2 + kv) * 64) * 4608; }
DEV u16* kd_ptr(char* ws, int bs, int hm) { return bs < 16 ? (u16*)(ws + OFF_KDC) + (size_t)((bs * 8 + hm) * 256) * 64 : (u16*)(ws + OFF_KDL) + (size_t)(((bs - 16) * 8 + hm) * 4608) * 64; }
DEV u16* vdt_ptr(char* ws, int bs, int h) { return bs < 16 ? (u16*)(ws + OFF_VDC) + (size_t)((bs * 4 + h) * 128) * 256 : (u16*)(ws + OFF_VDL) + (size_t)(((bs - 16) * 4 + h) * 128) * 4608; }
DEV u16* lvt_ptr(char* ws, int bs, int h) { return bs < 16 ? (u16*)(ws + OFF_LVT) + (size_t)((bs * 4 + h) * 128) * 256 : (u16*)(ws + OFF_LVT) + (size_t)2097152 + (size_t)(((bs - 16) * 4 + h) * 128) * 4096; }

template <int ROWS, int SW = 0>
DEV void stage_rows(const u16* g, unsigned ld, char* lds, int tid) {
    const int wbase = __builtin_amdgcn_readfirstlane(tid >> 6) * 64;
    const char* gb = (const char*)g;
#pragma unroll
    for (int i = 0; i < ROWS / 32; ++i) {
        const int idx = tid + i * 256;
        const int r = idx >> 3, s = idx & 7;
        const int c = s ^ (SW == 0 ? (r & 7) : ((r >> 1) & 7));
        const unsigned off = ((unsigned)r * ld + (unsigned)c * 8u) * 2u;
        __builtin_amdgcn_global_load_lds((const void*)(gb + off), (LAS void*)(lds + (wbase + i * 256) * 16), 16, 0, 0);
    }
}
DEV bf16x8 lds_frag(const char* tile, int row, int chunk) { return *(const bf16x8*)(tile + row * 128 + ((chunk ^ (row & 7)) << 4)); }
DEV bf16x8 lds_frag1(const char* tile, int row, int chunk) { return *(const bf16x8*)(tile + row * 128 + ((chunk ^ ((row >> 1) & 7)) << 4)); }
typedef float f32x16 __attribute__((ext_vector_type(16)));
DEV f32x16 mfma32(bf16x8 a, bf16x8 b, f32x16 c) { return __builtin_amdgcn_mfma_f32_32x32x16_bf16(a, b, c, 0, 0, 0); }
DEV void wait_vm0() { asm volatile("s_waitcnt vmcnt(0)" ::: "memory"); }

template <int NT, bool TR = false>
DEV void gemm_mainloop(f32x4 (&acc)[4][NT], const u16* A, unsigned lda, const u16* B, unsigned ldb, int K, char* lds, int tid) {
    constexpr int BN = NT * 32;
    constexpr int AB = 128 * 128, BB = BN * 128, STG = AB + BB;
    const int lane = tid & 63, wid = __builtin_amdgcn_readfirstlane(tid >> 6), wr = wid >> 1, wc = wid & 1, fr = lane & 15, fq = lane >> 4;
    const int nk = K >> 6;
    stage_rows<128>(A, lda, lds, tid);
    stage_rows<BN>(B, ldb, lds + AB, tid);
    for (int kt = 0; kt < nk; ++kt) {
        char* cur = lds + (kt & 1) * STG;
        wait_vm0();
        __syncthreads();
        if (kt + 1 < nk) {
            char* nxt = lds + ((kt + 1) & 1) * STG;
            stage_rows<128>(A + (size_t)(kt + 1) * 64, lda, nxt, tid);
            stage_rows<BN>(B + (size_t)(kt + 1) * 64, ldb, nxt + AB, tid);
        }
        {
            bf16x8 a[2][4], b[2][NT];
#pragma unroll
            for (int ks = 0; ks < 2; ++ks) {
#pragma unroll
                for (int m = 0; m < 4; ++m) a[ks][m] = lds_frag(cur, wr * 64 + m * 16 + fr, ks * 4 + fq);
#pragma unroll
                for (int n = 0; n < NT; ++n) b[ks][n] = lds_frag(cur + AB, wc * (NT * 16) + n * 16 + fr, ks * 4 + fq);
            }
            __builtin_amdgcn_sched_barrier(0);
#pragma unroll
            for (int ks = 0; ks < 2; ++ks)
#pragma unroll
                for (int m = 0; m < 4; ++m)
#pragma unroll
                    for (int n = 0; n < NT; ++n) acc[m][n] = TR ? mfma16(b[ks][n], a[ks][m], acc[m][n]) : mfma16(a[ks][m], b[ks][n], acc[m][n]);
        }
    }
    __syncthreads();
}

template <int NT>
DEV void zero_acc(f32x4 (&acc)[4][NT]) {
#pragma unroll
    for (int m = 0; m < 4; ++m)
#pragma unroll
        for (int n = 0; n < NT; ++n) acc[m][n] = (f32x4){0.f, 0.f, 0.f, 0.f};
}

template <int NT, bool TR>
DEV void gemm_chain(f32x4 (&acc)[4][NT], const u16* A, unsigned lda, const u16* B, unsigned ldb, int K,
                    bool has_next, const u16* nA, unsigned nlda, const u16* nB, unsigned nldb, int& par, bool& pre, char* lds, int tid) {
    constexpr int BN = NT * 32;
    constexpr int AB = 128 * 128, BB = BN * 128, STG = AB + BB;
    const int lane = tid & 63, wid = __builtin_amdgcn_readfirstlane(tid >> 6), wr = wid >> 1, wc = wid & 1, fr = lane & 15, fq = lane >> 4;
    const int nk = K >> 6;
    if (!pre) {
        stage_rows<128>(A, lda, lds + par * STG, tid);
        stage_rows<BN>(B, ldb, lds + par * STG + AB, tid);
    }
    for (int kt = 0; kt < nk; ++kt) {
        char* cur = lds + ((par + kt) & 1) * STG;
        char* nxt = lds + ((par + kt + 1) & 1) * STG;
        wait_vm0();
        __syncthreads();
        if (kt + 1 < nk) {
            stage_rows<128>(A + (size_t)(kt + 1) * 64, lda, nxt, tid);
            stage_rows<BN>(B + (size_t)(kt + 1) * 64, ldb, nxt + AB, tid);
        } else if (has_next) {
            stage_rows<128>(nA, nlda, nxt, tid);
            stage_rows<BN>(nB, nldb, nxt + AB, tid);
        }
        {
            bf16x8 a[2][4], b[2][NT];
#pragma unroll
            for (int ks = 0; ks < 2; ++ks) {
#pragma unroll
                for (int m = 0; m < 4; ++m) a[ks][m] = lds_frag(cur, wr * 64 + m * 16 + fr, ks * 4 + fq);
#pragma unroll
                for (int n = 0; n < NT; ++n) b[ks][n] = lds_frag(cur + AB, wc * (NT * 16) + n * 16 + fr, ks * 4 + fq);
            }
            __builtin_amdgcn_sched_barrier(0);
#pragma unroll
            for (int ks = 0; ks < 2; ++ks)
#pragma unroll
                for (int m = 0; m < 4; ++m)
#pragma unroll
                    for (int n = 0; n < NT; ++n) acc[m][n] = TR ? mfma16(b[ks][n], a[ks][m], acc[m][n]) : mfma16(a[ks][m], b[ks][n], acc[m][n]);
        }
    }
    par = (par + nk) & 1;
    pre = has_next;
    if (!has_next) __syncthreads();
}

template <int NT, bool TR>
DEV void gemm_chain2(f32x4 (&acc)[4][NT], const u16* A, unsigned lda, const u16* B, unsigned ldb, int K,
                     bool has_next, const u16* nA, unsigned nlda, const u16* nB, unsigned nldb, int& par, int& pre, char* lds, int tid) {
    constexpr int BN = NT * 32;
    constexpr int AB = 128 * 128, BB = BN * 128, STG = AB + BB;
    static_assert(NT == 2 || NT == 4, "vmcnt literals");
    const int lane = tid & 63, wid = __builtin_amdgcn_readfirstlane(tid >> 6), wr = wid >> 1, wc = wid & 1, fr = lane & 15, fq = lane >> 4;
    const int nk = K >> 6;
    if (pre < 1) { stage_rows<128>(A, lda, lds + par * STG, tid); stage_rows<BN>(B, ldb, lds + par * STG + AB, tid); }
    if (pre < 2) { stage_rows<128>(A + 64, lda, lds + (par ^ 1) * STG, tid); stage_rows<BN>(B + 64, ldb, lds + (par ^ 1) * STG + AB, tid); }
    for (int kt = 0; kt < nk; ++kt) {
        char* cur = lds + ((par + kt) & 1) * STG;
        const bool younger = (kt + 1 < nk) || has_next;
        if (kt == 0 || !younger) asm volatile("s_waitcnt vmcnt(0)" ::: "memory");
        else if (NT == 4) asm volatile("s_waitcnt vmcnt(8)" ::: "memory");
        else asm volatile("s_waitcnt vmcnt(6)" ::: "memory");
        __builtin_amdgcn_s_barrier();
        asm volatile("" ::: "memory");
        bf16x8 a[2][4], b[2][NT];
#pragma unroll
        for (int ks = 0; ks < 2; ++ks) {
#pragma unroll
            for (int m = 0; m < 4; ++m) a[ks][m] = lds_frag(cur, wr * 64 + m * 16 + fr, ks * 4 + fq);
#pragma unroll
            for (int n = 0; n < NT; ++n) b[ks][n] = lds_frag(cur + AB, wc * (NT * 16) + n * 16 + fr, ks * 4 + fq);
        }
        asm volatile("s_waitcnt lgkmcnt(0)" ::: "memory");
        __builtin_amdgcn_s_barrier();
        asm volatile("" ::: "memory");
        if (kt + 2 < nk) {
            stage_rows<128>(A + (size_t)(kt + 2) * 64, lda, cur, tid);
            stage_rows<BN>(B + (size_t)(kt + 2) * 64, ldb, cur + AB, tid);
        } else if (has_next) {
            const int j = kt + 2 - nk;
            stage_rows<128>(nA + (size_t)j * 64, nlda, cur, tid);
            stage_rows<BN>(nB + (size_t)j * 64, nldb, cur + AB, tid);
        }
        __builtin_amdgcn_sched_barrier(0);
#pragma unroll
        for (int ks = 0; ks < 2; ++ks)
#pragma unroll
            for (int m = 0; m < 4; ++m)
#pragma unroll
                for (int n = 0; n < NT; ++n) acc[m][n] = TR ? mfma16(b[ks][n], a[ks][m], acc[m][n]) : mfma16(a[ks][m], b[ks][n], acc[m][n]);
    }
    par = (par + nk) & 1;
    pre = has_next ? 2 : 0;
    if (!has_next) __syncthreads();
}

template <int NT, bool TR = false>
DEV void gemm_mainloop3(f32x4 (&acc)[4][NT], const u16* A, unsigned lda, const u16* B, unsigned ldb, int K, char* lds, int tid) {
    constexpr int BN = NT * 32;
    constexpr int AB = 128 * 128, BB = BN * 128, STG = AB + BB;
    static_assert(NT == 2, "vmcnt literal below assumes 6 DMA pieces per thread per tile");
    const int lane = tid & 63, wid = __builtin_amdgcn_readfirstlane(tid >> 6), wr = wid >> 1, wc = wid & 1, fr = lane & 15, fq = lane >> 4;
    const int nk = K >> 6;
    wait_vm0();
    stage_rows<128>(A, lda, lds, tid);
    stage_rows<BN>(B, ldb, lds + AB, tid);
    stage_rows<128>(A + 64, lda, lds + STG, tid);
    stage_rows<BN>(B + 64, ldb, lds + STG + AB, tid);
    int cb = 0;
    for (int kt = 0; kt < nk; ++kt) {
        char* cur = lds + cb * STG;
        if (kt + 1 < nk) asm volatile("s_waitcnt vmcnt(6)" ::: "memory");
        else asm volatile("s_waitcnt vmcnt(0)" ::: "memory");
        asm volatile("s_waitcnt lgkmcnt(0)" ::: "memory");
        __builtin_amdgcn_s_barrier();
        asm volatile("" ::: "memory");
        if (kt + 2 < nk) {
            const int nb = cb == 0 ? 2 : cb - 1;
            char* nxt = lds + nb * STG;
            stage_rows<128>(A + (size_t)(kt + 2) * 64, lda, nxt, tid);
            stage_rows<BN>(B + (size_t)(kt + 2) * 64, ldb, nxt + AB, tid);
        }
        {
            bf16x8 a[2][4], b[2][NT];
#pragma unroll
            for (int ks = 0; ks < 2; ++ks) {
#pragma unroll
                for (int m = 0; m < 4; ++m) a[ks][m] = lds_frag(cur, wr * 64 + m * 16 + fr, ks * 4 + fq);
#pragma unroll
                for (int n = 0; n < NT; ++n) b[ks][n] = lds_frag(cur + AB, wc * (NT * 16) + n * 16 + fr, ks * 4 + fq);
            }
            __builtin_amdgcn_sched_barrier(0);
#pragma unroll
            for (int ks = 0; ks < 2; ++ks)
#pragma unroll
                for (int m = 0; m < 4; ++m)
#pragma unroll
                    for (int n = 0; n < NT; ++n) acc[m][n] = TR ? mfma16(b[ks][n], a[ks][m], acc[m][n]) : mfma16(a[ks][m], b[ks][n], acc[m][n]);
        }
        cb = cb == 2 ? 0 : cb + 1;
    }
    __syncthreads();
}

DEV int win_map(int c) { return c < 1792 ? c : (c < 3840 ? c + 32 : (c < 3872 ? c - 2048 : (c < 3968 ? -1 : c - 96))); }
DEV int wfi_map(int c) { const int tn = c >> 7, wc = (c >> 6) & 1, nt = (c >> 4) & 3, fr = c & 15; return (nt >> 1) * 2816 + tn * 64 + wc * 32 + (nt & 1) * 16 + fr; }

DEV void conv_tile(const float* src, size_t ld, int K, int kind, int n0, int k0, u16* dst, char* lds, int tid) {
    float* tile = (float*)lds;
    const int c = tid & 63;
    const int nn = n0 + c;
    const int sc = kind == 0 ? win_map(nn) : (kind == 3 ? wfi_map(nn) : nn);
    const int kb = tid >> 6;
    float v[32];
#pragma unroll
    for (int i = 0; i < 32; ++i) v[i] = sc >= 0 ? src[(size_t)(k0 + i * 4 + kb) * ld + sc] : 0.f;
#pragma unroll
    for (int i = 0; i < 32; ++i) tile[(i * 4 + kb) * 65 + c] = v[i];
    __syncthreads();
    const int nrow = tid >> 2, kq = tid & 3;
    unsigned w[16];
#pragma unroll
    for (int i = 0; i < 16; ++i) w[i] = pack2(tile[(kq * 32 + 2 * i) * 65 + nrow], tile[(kq * 32 + 2 * i + 1) * 65 + nrow]);
    u16* d = dst + (size_t)(n0 + nrow) * K + k0 + kq * 32;
#pragma unroll
    for (int i = 0; i < 4; ++i) *(u32x4*)(d + i * 8) = (u32x4){w[4 * i], w[4 * i + 1], w[4 * i + 2], w[4 * i + 3]};
    __syncthreads();
}

constexpr int NCONV = 880 + 192 + 128 + 704 + 352;
DEV void conv_item(const Params& p, int l, int it, char* lds, int tid) {
    char* ws = p.ws;
    if (it < 880) { conv_tile(p.w_in + (size_t)l * 1024 * NIN_SRC, NIN_SRC, 1024, 0, (it >> 3) * 64, (it & 7) * 128, (u16*)(ws + OFF_WIN), lds, tid); return; }
    it -= 880;
    if (it < 192) { const int i = it / 64, r = it % 64; conv_tile(p.w_branch + (size_t)(l * 3 + i) * 512 * 1024, 1024, 512, 1, (r >> 2) * 64, (r & 3) * 128, (u16*)(ws + OFF_WBR) + (size_t)i * 1024 * 512, lds, tid); return; }
    it -= 192;
    if (it < 128) { conv_tile(p.w_out + (size_t)l * 1024 * 1024, 1024, 1024, 2, (it >> 3) * 64, (it & 7) * 128, (u16*)(ws + OFF_WOUT), lds, tid); return; }
    it -= 128;
    if (it < 704) { conv_tile(p.w_ffn_in + (size_t)l * 1024 * 5632, 5632, 1024, 3, (it >> 3) * 64, (it & 7) * 128, (u16*)(ws + OFF_WFI), lds, tid); return; }
    it -= 704;
    { conv_tile(p.w_ffn_out + (size_t)l * 2816 * 1024, 1024, 2816, 4, (it / 22) * 64, (it % 22) * 128, (u16*)(ws + OFF_WFO), lds, tid); }
}

constexpr int NMOD = 384;
DEV void mod_item(const Params& p, int it, char* lds, int tid) {
    const int l = it / 192, cb = it % 192;
    float* sc = (float*)lds;
    float* red = (float*)(lds + 12288);
    for (int i = tid; i < 3072; i += 256) {
        const int cnd = i >> 10, k = i & 1023;
        const float v = cnd == 0 ? p.c_ctx[k] : p.c[(cnd - 1) * 1024 + k];
        sc[i] = siluf_(v);
    }
    __syncthreads();
    const int cgp = tid & 7, kg = tid >> 3;
    float acc[3][4];
#pragma unroll
    for (int a = 0; a < 3; ++a)
#pragma unroll
        for (int b = 0; b < 4; ++b) acc[a][b] = 0.f;
    const float* wbase = p.w_mod + (size_t)l * 1024 * 6144 + cb * 32 + cgp * 4;
#pragma unroll 16
    for (int kk = 0; kk < 32; ++kk) {
        const int k = kg * 32 + kk;
        const float4 w = *(const float4*)(wbase + (size_t)k * 6144);
#pragma unroll
        for (int a = 0; a < 3; ++a) { const float sv = sc[a * 1024 + k]; acc[a][0] += sv * w.x; acc[a][1] += sv * w.y; acc[a][2] += sv * w.z; acc[a][3] += sv * w.w; }
    }
#pragma unroll
    for (int a = 0; a < 3; ++a)
#pragma unroll
        for (int b = 0; b < 4; ++b) red[(kg * 3 + a) * 32 + cgp * 4 + b] = acc[a][b];
    __syncthreads();
    if (tid < 96) {
        const int a = tid >> 5, col = tid & 31;
        float sum = p.b_mod[l * 6144 + cb * 32 + col];
#pragma unroll
        for (int g = 0; g < 32; ++g) sum += red[(g * 3 + a) * 32 + col];
        ((float*)(p.ws + OFF_MOD))[(l * 3 + a) * 6144 + cb * 32 + col] = sum;
    }
    __syncthreads();
}

DEV void rope_item(const Params& p, int tid) {
    float* tab = (float*)(p.ws + OFF_ROPE);
    for (int i = tid; i < 1024; i += 256) {
        const int pos = i >> 4, f = i & 15;
        const float freq = powf(10000.0f, -(float)f / 16.0f);
        const float ang = (float)pos * freq;
        tab[i * 2] = cosf(ang);
        tab[i * 2 + 1] = sinf(ang);
    }
}

constexpr int NCACHE = 1280;
DEV void cache_item(const Params& p, int l, int it, int tid) {
    char* ws = p.ws;
    float v[4];
    size_t doff[4];
    u16* dbase[4];
#pragma unroll
    for (int u = 0; u < 4; ++u) {
        const int idx = it * 1024 + u * 256 + tid;
        const int bp = idx / 1280, r = idx % 1280;
        const int b = bp >> 9, pp = bp & 511;
        const size_t srow = (size_t)((b * 2 + l) * 512 + pp);
        if (r < 128) { const int kv = r >> 6, d = r & 63; dbase[u] = (u16*)(ws + OFF_KGL); doff[u] = (size_t)((b * 2 + kv) * 4608 + 4096 + pp) * 64 + d; v[u] = p.cache_gqa_k[srow * 128 + r]; }
        else if (r < 256) { const int r2 = r - 128, kv = r2 >> 6, d = r2 & 63; dbase[u] = (u16*)(ws + OFF_VGL); doff[u] = (size_t)((b * 2 + kv) * 64 + d) * 4608 + 4096 + pp; v[u] = p.cache_gqa_v[srow * 128 + r2]; }
        else if (r < 768) { const int r2 = r - 256, hm = r2 >> 6, d = r2 & 63; dbase[u] = (u16*)(ws + OFF_KDL); doff[u] = (size_t)((b * 8 + hm) * 4608 + 4096 + pp) * 64 + d; v[u] = p.cache_diff_k[srow * 512 + r2]; }
        else { const int r2 = r - 768, h = r2 >> 7, e = r2 & 127; dbase[u] = (u16*)(ws + OFF_VDL); doff[u] = (size_t)((b * 4 + h) * 128 + e) * 4608 + 4096 + pp; v[u] = p.cache_diff_v[srow * 512 + r2]; }
    }
#pragma unroll
    for (int u = 0; u < 4; ++u) dbase[u][doff[u]] = f2bf(v[u]);
}

template <int RW = 4>
DEV void norm_item(const Params& p, int l, int which, int it, int tid) {
    const int lane = tid & 63, wid = __builtin_amdgcn_readfirstlane(tid >> 6);
    const int tb = it * (4 * RW) + wid * RW;
    const float* g = (which == 0 ? p.norm1 : p.norm2) + l * 1024;
    const float* mod = (const float*)(p.ws + OFF_MOD) + (size_t)(l * 3 + tok_cond(tb)) * 6144 + (which == 0 ? 0 : 3072);
    float4 v[RW][4];
#pragma unroll
    for (int r = 0; r < RW; ++r) {
        const int t = tb + r;
        const float* xr;
        if (which == 0 && l == 0) xr = t < 4096 ? p.x_prompt + (size_t)t * 1024 : p.x_sample + (size_t)(t - 4096) * 1024;
        else xr = p.out + (size_t)t * 1024;
#pragma unroll
        for (int i = 0; i < 4; ++i) v[r][i] = *(const float4*)(xr + i * 256 + lane * 4);
    }
    float4 gg[4], sh[4], scv[4];
#pragma unroll
    for (int i = 0; i < 4; ++i) {
        const int e = i * 256 + lane * 4;
        gg[i] = *(const float4*)(g + e); sh[i] = *(const float4*)(mod + e); scv[i] = *(const float4*)(mod + 1024 + e);
        gg[i].x *= 1.f + scv[i].x; gg[i].y *= 1.f + scv[i].y; gg[i].z *= 1.f + scv[i].z; gg[i].w *= 1.f + scv[i].w;
    }
#pragma unroll
    for (int r = 0; r < RW; ++r) {
        float ss = 0.f;
#pragma unroll
        for (int i = 0; i < 4; ++i) ss += v[r][i].x * v[r][i].x + v[r][i].y * v[r][i].y + v[r][i].z * v[r][i].z + v[r][i].w * v[r][i].w;
#pragma unroll
        for (int o = 1; o < 64; o <<= 1) ss += __shfl_xor(ss, o);
        const float rstd = rsqrtf(ss * (1.0f / 1024.0f) + EPSV);
        u16* hr = (u16*)(p.ws + OFF_H) + (size_t)(tb + r) * 1024;
#pragma unroll
        for (int i = 0; i < 4; ++i) {
            const int e = i * 256 + lane * 4;
            const float a = v[r][i].x * rstd * gg[i].x + sh[i].x;
            const float b = v[r][i].y * rstd * gg[i].y + sh[i].y;
            const float c = v[r][i].z * rstd * gg[i].z + sh[i].z;
            const float d = v[r][i].w * rstd * gg[i].w + sh[i].w;
            *(u32x2*)(hr + e) = (u32x2){pack2(a, b), pack2(c, d)};
        }
    }
}

DEV void acc_to_rows(const f32x4 (&acc)[4][4], char* lds, int wid, int lane_in, float (&v)[64]) {
    int lane = lane_in;
    asm volatile("" : "+v"(lane));
    float* wt = (float*)(lds + wid * 16384);
    const int fr = lane & 15, fq = lane >> 4;
    int bj[4], bn[4];
#pragma unroll
    for (int j = 0; j < 4; ++j) bj[j] = fq * 256 + (fr ^ (4 * j)) + j * 64;
#pragma unroll
    for (int n = 0; n < 4; ++n) bn[n] = 16 * (n ^ fq);
#pragma unroll
    for (int m = 0; m < 4; ++m)
#pragma unroll
        for (int n = 0; n < 4; ++n)
#pragma unroll
            for (int j = 0; j < 4; ++j) wt[bj[j] + bn[n] + m * 1024] = acc[m][n][j];
    __syncthreads();
#pragma unroll
    for (int c4 = 0; c4 < 16; ++c4) {
        const float4 x = *(const float4*)(wt + lane * 64 + ((c4 ^ (lane & 15)) << 2));
        v[c4 * 4] = x.x; v[c4 * 4 + 1] = x.y; v[c4 * 4 + 2] = x.z; v[c4 * 4 + 3] = x.w;
    }
    __syncthreads();
}

DEV void row_norm_rope(float (&v)[64], const float* gain, bool rope, int n, const float* tab, float scale) {
    float ss = 0.f;
#pragma unroll
    for (int c = 0; c < 64; ++c) ss += v[c] * v[c];
    const float r = rsqrtf(ss * (1.0f / 64.0f) + EPSV);
#pragma unroll
    for (int c = 0; c < 64; ++c) v[c] = v[c] * r * gain[c];
    if (rope) {
        const int rp = n >> 6, cp = n & 63;
#pragma unroll
        for (int i = 0; i < 16; ++i) {
            const float2 a = *(const float2*)(tab + (rp * 16 + i) * 2);
            const float2 b = *(const float2*)(tab + (cp * 16 + i) * 2);
            const float x0 = v[i], x1 = v[16 + i], x2 = v[32 + i], x3 = v[48 + i];
            v[i] = x0 * a.x - x1 * a.y; v[16 + i] = x1 * a.x + x0 * a.y;
            v[32 + i] = x2 * b.x - x3 * b.y; v[48 + i] = x3 * b.x + x2 * b.y;
        }
    }
#pragma unroll
    for (int c = 0; c < 64; ++c) v[c] *= scale;
}
DEV void row_store_bf16(const float (&v)[64], u16* dst0, size_t ld, char* wl, int lane) {
#pragma unroll
    for (int i = 0; i < 8; ++i)
        *(u32x4*)(wl + lane * 128 + ((i ^ (lane & 7)) << 4)) = (u32x4){pack2(v[i * 8], v[i * 8 + 1]), pack2(v[i * 8 + 2], v[i * 8 + 3]), pack2(v[i * 8 + 4], v[i * 8 + 5]), pack2(v[i * 8 + 6], v[i * 8 + 7])};
    __builtin_amdgcn_wave_barrier();
    const int c = lane & 7;
#pragma unroll
    for (int i = 0; i < 8; ++i) {
        const int row = i * 8 + (lane >> 3);
        const u32x4 x = *(const u32x4*)(wl + row * 128 + ((c ^ (row & 7)) << 4));
        *(u32x4*)(dst0 + (size_t)row * ld + c * 8) = x;
    }
}
DEV void row_store_f32(const float (&v)[64], float* dst) {
#pragma unroll
    for (int i = 0; i < 16; ++i) *(float4*)(dst + i * 4) = make_float4(v[i * 4], v[i * 4 + 1], v[i * 4 + 2], v[i * 4 + 3]);
}
DEV void col_store_bf16(const float (&v)[64], u16* dst, size_t ld) {
#pragma unroll
    for (int c = 0; c < 64; ++c) dst[(size_t)c * ld] = f2bf(v[c]);
}

DEV void p1_tile(const Params& p, int l, int tile, char* lds, int tid) {
    char* ws = p.ws;
    const int tm = tile % 96, tn = tile / 96;
    const int lane = tid & 63, wid = __builtin_amdgcn_readfirstlane(tid >> 6), wr = wid >> 1, wc = wid & 1;
    float v[64];
    {
        f32x4 acc[4][4];
        zero_acc<4>(acc);
        gemm_mainloop<4>(acc, (const u16*)(ws + OFF_H) + (size_t)tm * 128 * 1024, 1024, (const u16*)(ws + OFF_WIN) + (size_t)tn * 128 * 1024, 1024, 1024, lds, tid);
        acc_to_rows(acc, lds, wid, lane, v);
    }
    const int t0 = tm * 128 + wr * 64;
    const bool lat = t0 >= 4096;
    const int bs = tok_bs(t0), n0 = tok_n(t0);
    const int t = t0 + lane, n = n0 + lane;
    char* wl = lds + wid * 16384;
    const float* tab = (const float*)(ws + OFF_ROPE);
    const int S = lat ? 4608 : 256;
    const int col = tn * 128 + wc * 64;
    if (tn < 4) {
        row_norm_rope(v, p.gqa_q_norm + l * 64, lat, n, tab, QSCALE);
        row_store_bf16(v, (u16*)(ws + OFF_QG) + (size_t)t0 * 512 + col, 512, wl, lane);
    } else if (tn == 4) {
        const int kv = wc;
        row_norm_rope(v, p.gqa_k_norm + l * 64, lat, n, tab, 1.0f);
        row_store_bf16(v, kg_ptr(ws, bs, kv) + (size_t)n0 * 64, 64, wl, lane);
        if (!lat) row_store_f32(v, p.out + OUT_GK + (size_t)((bs * 2 + l) * 256 + n) * 128 + kv * 64);
    } else if (tn == 5) {
        const int kv = wc;
        col_store_bf16(v, vgt_ptr(ws, bs, kv) + n, S);
        if (!lat) row_store_f32(v, p.out + OUT_GV + (size_t)((bs * 2 + l) * 256 + n) * 128 + kv * 64);
    } else if (tn < 8) {
#pragma unroll
        for (int c = 0; c < 64; ++c) v[c] *= 0.125f;
        row_store_bf16(v, (u16*)(ws + OFF_LQ) + (size_t)t0 * 256 + (col - 768), 256, wl, lane);
    } else if (tn < 10) {
        row_store_bf16(v, (u16*)(ws + OFF_LK) + (size_t)t0 * 256 + (col - 1024), 256, wl, lane);
    } else if (tn < 14) {
        const int c2 = col - 1280, h = c2 >> 7, e0 = c2 & 127;
        const int N = lat ? 4096 : 256;
        col_store_bf16(v, lvt_ptr(ws, bs, h) + (size_t)e0 * N + n, N);
    } else if (tn < 18) {
#pragma unroll
        for (int c = 0; c < 64; ++c) v[c] = siluf_(v[c]);
        row_store_bf16(v, (u16*)(ws + OFF_LGO) + (size_t)t0 * 512 + (col - 1792), 512, wl, lane);
    } else if (tn < 22) {
        row_norm_rope(v, p.diff_q_norm + l * 64, lat, n, tab, QSCALE);
        row_store_bf16(v, (u16*)(ws + OFF_QD) + (size_t)t0 * 512 + (col - 2304), 512, wl, lane);
    } else if (tn < 26) {
        const int hm = (col - 2816) >> 6;
        row_norm_rope(v, p.diff_k_norm + l * 64, lat, n, tab, 1.0f);
        row_store_bf16(v, kd_ptr(ws, bs, hm) + (size_t)n0 * 64, 64, wl, lane);
        if (!lat) row_store_f32(v, p.out + OUT_DK + (size_t)((bs * 2 + l) * 256 + n) * 512 + hm * 64);
    } else if (tn < 30) {
        const int c2 = col - 3328, h = c2 >> 7, e0 = c2 & 127;
        col_store_bf16(v, vdt_ptr(ws, bs, h) + (size_t)e0 * S + n, S);
        if (!lat) row_store_f32(v, p.out + OUT_DV + (size_t)((bs * 2 + l) * 256 + n) * 512 + c2);
    } else {
        if (wc == 0) {
            float* lr = (float*)(ws + OFF_LR) + (size_t)t * 32;
#pragma unroll
            for (int i = 0; i < 8; ++i) *(float4*)(lr + i * 4) = make_float4(v[i * 4], v[i * 4 + 1], v[i * 4 + 2], v[i * 4 + 3]);
        }
    }
    __syncthreads();
}

template <int DV>
DEV void attn_item(const u16* Qbase, int qcol, int trow0, const u16* Kp, const u16* VTp, int S, u16* Obase, int ostride, int ocol, char* lds, int tid) {
    const int lane = tid & 63, wid = __builtin_amdgcn_readfirstlane(tid >> 6), q = lane & 31, h = lane >> 5;
    constexpr int NDT = DV / 32;
    constexpr int KB = 64 * 128, VB = DV * 128;
    char* Kr = lds;
    char* Vr = lds + 3 * KB;
    bf16x8 qf[4];
#pragma unroll
    for (int ks = 0; ks < 4; ++ks) qf[ks] = *(const bf16x8*)(Qbase + (size_t)(trow0 + wid * 32 + q) * 512 + qcol + ks * 16 + h * 8);
    f32x16 o[NDT];
#pragma unroll
    for (int d = 0; d < NDT; ++d)
#pragma unroll
        for (int r = 0; r < 16; ++r) o[d][r] = 0.f;
    float m = 0.f, l = 0.f;
    float lo_thr = -8.0f;
    const int krow = (q & 19) | ((q & 4) << 1) | ((q & 8) >> 1);
    const int nt = S >> 6;
    auto qk = [&](f32x16 (&sc)[2], const char* kb) {
#pragma unroll
        for (int mt = 0; mt < 2; ++mt) {
            bf16x8 kf[4];
#pragma unroll
            for (int ks = 0; ks < 4; ++ks) kf[ks] = lds_frag1(kb, mt * 32 + krow, ks * 2 + h);
#pragma unroll
            for (int r = 0; r < 16; ++r) sc[mt][r] = 0.f;
#pragma unroll
            for (int ks = 0; ks < 4; ++ks) sc[mt] = mfma32(kf[ks], qf[ks], sc[mt]);
        }
    };
    auto step = [&](int it, f32x16 (&s)[2], f32x16 (&sn)[2]) {
        if (it > 0) { wait_vm0(); __syncthreads(); }
        if (it + 1 < nt) stage_rows<DV, 1>(VTp + (size_t)(it + 1) * 64, (unsigned)S, Vr + ((it + 1) & 1) * VB, tid);
        if (it + 2 < nt) stage_rows<64, 1>(Kp + (size_t)(it + 2) * 64 * 64, 64, Kr + ((it + 2) % 3) * KB, tid);
        float mx = fmaxf(fmaxf(s[0][0], s[0][1]), s[0][2]);
#pragma unroll
        for (int r = 3; r < 15; r += 2) mx = fmaxf(fmaxf(mx, s[0][r]), s[0][r + 1]);
        mx = fmaxf(fmaxf(mx, s[0][15]), s[1][0]);
#pragma unroll
        for (int r = 1; r < 15; r += 2) mx = fmaxf(fmaxf(mx, s[1][r]), s[1][r + 1]);
        mx = fmaxf(mx, s[1][15]);
        mx = fmaxf(mx, __shfl_xor(mx, 32));
        const float rel = mx - m;
        const bool mv = rel > 8.0f || rel < lo_thr;
        lo_thr = -3.0e38f;
        if (__any(mv)) {
            const float delta = mv ? rel : 0.f;
            m += delta;
            const float alpha = delta > 0.f ? __builtin_amdgcn_exp2f(-delta) : 1.0f;
            l *= alpha;
#pragma unroll
            for (int d = 0; d < NDT; ++d) o[d] = o[d] * alpha;
        }
        if (__any(m != 0.f)) { s[0] = s[0] - m; s[1] = s[1] - m; }
        qk(sn, Kr + ((it + 1) % 3) * KB);
#pragma unroll
        for (int mt = 0; mt < 2; ++mt)
#pragma unroll
            for (int r = 0; r < 16; ++r) s[mt][r] = __builtin_amdgcn_exp2f(s[mt][r]);
        {
            float a0 = s[0][0] + s[1][0], a1 = s[0][1] + s[1][1], a2 = s[0][2] + s[1][2], a3 = s[0][3] + s[1][3];
#pragma unroll
            for (int r = 4; r < 16; r += 4) { a0 += s[0][r] + s[1][r]; a1 += s[0][r + 1] + s[1][r + 1]; a2 += s[0][r + 2] + s[1][r + 2]; a3 += s[0][r + 3] + s[1][r + 3]; }
            l += (a0 + a1) + (a2 + a3);
        }
        bf16x8 pf[4];
#pragma unroll
        for (int kk = 0; kk < 4; ++kk) {
            const int mt = kk >> 1, t = (kk & 1) * 8;
            u32x4 w;
            w.x = pack2(s[mt][t], s[mt][t + 1]); w.y = pack2(s[mt][t + 2], s[mt][t + 3]);
            w.z = pack2(s[mt][t + 4], s[mt][t + 5]); w.w = pack2(s[mt][t + 6], s[mt][t + 7]);
            pf[kk] = __builtin_bit_cast(bf16x8, w);
        }
        __builtin_amdgcn_sched_group_barrier(0x100, 8, 0);
#pragma unroll
        for (int i = 0; i < 8; ++i) {
            __builtin_amdgcn_sched_group_barrier(0x008, 1, 0);
            __builtin_amdgcn_sched_group_barrier(0x002, 8, 0);
        }
        asm volatile("" ::: "memory");
        const char* vb = Vr + (it & 1) * VB;
#pragma unroll
        for (int dt = 0; dt < NDT; ++dt) {
            bf16x8 vf[4];
#pragma unroll
            for (int kk = 0; kk < 4; ++kk) vf[kk] = lds_frag1(vb, dt * 32 + q, kk * 2 + h);
#pragma unroll
            for (int kk = 0; kk < 4; ++kk) o[dt] = mfma32(vf[kk], pf[kk], o[dt]);
        }
    };
    wait_vm0();
    stage_rows<64, 1>(Kp, 64, Kr, tid);
    stage_rows<DV, 1>(VTp, (unsigned)S, Vr, tid);
    stage_rows<64, 1>(Kp + (size_t)64 * 64, 64, Kr + KB, tid);
    wait_vm0();
    __syncthreads();
    f32x16 sa[2], sb[2];
    qk(sa, Kr);
    for (int it = 0; it < nt; it += 2) {
        step(it, sa, sb);
        step(it + 1, sb, sa);
    }
    __syncthreads();
    l += __shfl_xor(l, 32);
    const float inv = 1.0f / l;
    u16* orow = Obase + (size_t)(trow0 + wid * 32 + q) * ostride + ocol + 4 * h;
#pragma unroll
    for (int d = 0; d < NDT; ++d)
#pragma unroll
        for (int g = 0; g < 4; ++g)
            *(u32x2*)(orow + 32 * d + 8 * g) = (u32x2){pack2(o[d][4 * g] * inv, o[d][4 * g + 1] * inv), pack2(o[d][4 * g + 2] * inv, o[d][4 * g + 3] * inv)};
}

DEV void gla1_item(const Params& p, int l, int it, char* lds, int tid) {
    char* ws = p.ws;
    const int gch = it >> 2, h = it & 3;
    const int t0 = gch * 64;
    const int bs = tok_bs(t0), n0 = tok_n(t0);
    const int N = bs < 16 ? 256 : 4096;
    const int lane = tid & 63, wid = __builtin_amdgcn_readfirstlane(tid >> 6), fr = lane & 15, fq = lane >> 4;
    float* lrS = (float*)lds;
    char* vT = lds + 8192;
    char* Qd = lds + 24576;
    char* Ki = lds + 32768;
    char* KteT = lds + 40960;
    char* Am = lds + 49152;
    float* tot = (float*)(lds + 57344);
    stage_rows<128>(lvt_ptr(ws, bs, h) + n0, (unsigned)N, vT, tid);
    const int d = tid & 63, qt = __builtin_amdgcn_readfirstlane(tid >> 6);
    float4 lr0, lr1;
    {
        const float4* src = (const float4*)((const float*)(ws + OFF_LR) + (size_t)t0 * 32);
        lr0 = src[tid]; lr1 = src[tid + 256];
    }
    u16 qraw[16], kraw[16];
#pragma unroll
    for (int jj = 0; jj < 16; ++jj) {
        const size_t gi = (size_t)(t0 + qt * 16 + jj) * 256 + h * 64 + d;
        qraw[jj] = ((const u16*)(ws + OFF_LQ))[gi];
        kraw[jj] = ((const u16*)(ws + OFF_LK))[gi];
    }
    float up[16], upn[16];
#pragma unroll
    for (int r = 0; r < 16; ++r) up[r] = p.gla_alpha_up[((size_t)(l * 2) * 16 + r) * 256 + h * 64 + d];
    float bias = p.gla_alpha_bias[(l * 2) * 256 + h * 64 + d], biasn;
    ((float4*)lrS)[tid] = lr0;
    ((float4*)lrS)[tid + 256] = lr1;
    wait_vm0();
    __syncthreads();
    f32x4 oacc[8];
#pragma unroll
    for (int n = 0; n < 8; ++n) oacc[n] = (f32x4){0.f, 0.f, 0.f, 0.f};
#pragma unroll 1
    for (int dir = 0; dir < 2; ++dir) {
        const int cc = (gch * 4 + h) * 2 + dir;
#pragma unroll
        for (int r = 0; r < 16; ++r) upn[r] = p.gla_alpha_up[((size_t)(l * 2 + 1) * 16 + r) * 256 + h * 64 + d];
        biasn = p.gla_alpha_bias[(l * 2 + 1) * 256 + h * 64 + d];
        float la[16];
        float run = 0.f;
#pragma unroll
        for (int jj = 0; jj < 16; ++jj) {
            const float4* lp = (const float4*)(lrS + (qt * 16 + jj) * 32 + dir * 16);
            float z = bias;
#pragma unroll
            for (int r4 = 0; r4 < 4; ++r4) { const float4 x = lp[r4]; z += x.x * up[r4 * 4] + x.y * up[r4 * 4 + 1] + x.z * up[r4 * 4 + 2] + x.w * up[r4 * 4 + 3]; }
            la[jj] = (fminf(z, 0.f) - __logf(1.0f + __expf(-fabsf(z)))) * (1.0f / 16.0f);
            run += la[jj];
            asm volatile("" ::: "memory");
        }
        tot[qt * 64 + d] = run;
        __syncthreads();
        float offs = 0.f, total = 0.f;
#pragma unroll
        for (int q2 = 0; q2 < 4; ++q2) {
            const float tv = tot[q2 * 64 + d];
            total += tv;
            if (dir == 0 ? (q2 < qt) : (q2 > qt)) offs += tv;
        }
        float cpre = dir == 0 ? offs : offs + run;
#pragma unroll
        for (int j4 = 0; j4 < 4; ++j4) {
            float kt4[4];
#pragma unroll
            for (int u = 0; u < 4; ++u) {
                const int jj = j4 * 4 + u;
                const int j = qt * 16 + jj;
                float cv;
                if (dir == 0) { cpre += la[jj]; cv = cpre; } else { cv = cpre; cpre -= la[jj]; }
                const float qv = bf2f(qraw[jj]);
                const float kv = bf2f(kraw[jj]);
                const u16 qd = f2bf(qv * __expf(cv));
                const u16 ki = f2bf(kv * __expf(-cv));
                kt4[u] = kv * __expf(total - cv);
                const int so = j * 128 + ((((d >> 3) ^ (j & 7))) << 4) + (d & 7) * 2;
                *(u16*)(Qd + so) = qd;
                *(u16*)(Ki + so) = ki;
                ((u16*)(ws + OFF_QDG))[(size_t)dir * NTOK * 256 + (size_t)(t0 + j) * 256 + h * 64 + d] = qd;
                asm volatile("" ::: "memory");
            }
            const int j0 = qt * 16 + j4 * 4;
            *(u32x2*)(KteT + d * 128 + ((((j0 >> 3) ^ (d & 7))) << 4) + (j0 & 4) * 2) = (u32x2){pack2(kt4[0], kt4[1]), pack2(kt4[2], kt4[3])};
        }
        if (qt == 0) ((float*)(ws + OFF_DECAY))[(size_t)cc * 64 + d] = __expf(total);
        __syncthreads();
        {
            f32x4 sacc[4];
#pragma unroll
            for (int n = 0; n < 4; ++n) sacc[n] = (f32x4){0.f, 0.f, 0.f, 0.f};
#pragma unroll
            for (int ks = 0; ks < 2; ++ks) {
                const bf16x8 a = lds_frag(Qd, wid * 16 + fr, ks * 4 + fq);
#pragma unroll
                for (int n = 0; n < 4; ++n) sacc[n] = mfma16(a, lds_frag(Ki, n * 16 + fr, ks * 4 + fq), sacc[n]);
            }
#pragma unroll
            for (int n = 0; n < 4; ++n)
#pragma unroll
                for (int r = 0; r < 4; ++r) {
                    const int i = wid * 16 + fq * 4 + r, j = n * 16 + fr;
                    const bool keep = dir == 0 ? (j <= i) : (j >= i);
                    *(u16*)(Am + i * 128 + ((((j >> 3) ^ (i & 7))) << 4) + (j & 7) * 2) = keep ? f2bf(sacc[n][r]) : (u16)0;
                }
            f32x4 dacc[2][4];
#pragma unroll
            for (int mt = 0; mt < 2; ++mt)
#pragma unroll
                for (int n = 0; n < 4; ++n) dacc[mt][n] = (f32x4){0.f, 0.f, 0.f, 0.f};
#pragma unroll
            for (int ks = 0; ks < 2; ++ks) {
                bf16x8 b[4];
#pragma unroll
                for (int n = 0; n < 4; ++n) b[n] = lds_frag(KteT, n * 16 + fr, ks * 4 + fq);
#pragma unroll
                for (int mt = 0; mt < 2; ++mt) {
                    const bf16x8 a = lds_frag(vT, wid * 32 + mt * 16 + fr, ks * 4 + fq);
#pragma unroll
                    for (int n = 0; n < 4; ++n) dacc[mt][n] = mfma16(a, b[n], dacc[mt][n]);
                }
            }
            u16* dst = (u16*)(ws + OFF_DST) + (size_t)cc * 8192;
#pragma unroll
            for (int mt = 0; mt < 2; ++mt)
#pragma unroll
                for (int n = 0; n < 4; ++n)
#pragma unroll
                    for (int r = 0; r < 4; ++r) dst[(wid * 32 + mt * 16 + fq * 4 + r) * 64 + n * 16 + fr] = f2bf(dacc[mt][n][r]);
        }
        __syncthreads();
#pragma unroll
        for (int ks = 0; ks < 2; ++ks) {
            const bf16x8 a = lds_frag(Am, wid * 16 + fr, ks * 4 + fq);
#pragma unroll
            for (int n = 0; n < 8; ++n) oacc[n] = mfma16(a, lds_frag(vT, n * 16 + fr, ks * 4 + fq), oacc[n]);
        }
        __syncthreads();
#pragma unroll
        for (int r = 0; r < 16; ++r) up[r] = upn[r];
        bias = biasn;
    }
    u32x2* oi = (u32x2*)(ws + OFF_OI) + ((size_t)it * 4 + wid) * 8 * 64;
#pragma unroll
    for (int n = 0; n < 8; ++n) oi[n * 64 + lane] = (u32x2){pack2(oacc[n][0], oacc[n][1]), pack2(oacc[n][2], oacc[n][3])};
}

DEV void scan_item(const Params& p, int l, int it, int tid) {
    char* ws = p.ws;
    const u16* __restrict__ dst = (const u16*)(ws + OFF_DST);
    u16* __restrict__ sp = (u16*)(ws + OFF_SPREV);
    const float* __restrict__ dec = (const float*)(ws + OFF_DECAY);
    const int d = tid & 63, wv = __builtin_amdgcn_readfirstlane(tid >> 6);
    if (it < 512) {
        const int bs = 16 + (it >> 8), rem = it & 255;
        const int h = rem >> 6, dir = (rem >> 5) & 1, eb = rem & 31;
        const int e = eb * 4 + wv;
        const int gbase = 64 + (bs - 16) * 64;
        float s = p.state_gla[((size_t)((((bs - 16) * 2 + l) * 2 + dir) * 4 + h)) * 8192 + d * 128 + e];
#pragma unroll 1
        for (int st0 = 0; st0 < 64; st0 += 32) {
            float dv[32], xv[32];
#pragma unroll
            for (int u = 0; u < 32; ++u) {
                const int c = dir == 0 ? st0 + u : 63 - (st0 + u);
                const size_t ci = (size_t)((gbase + c) * 4 + h) * 2 + dir;
                dv[u] = dec[ci * 64 + d];
                xv[u] = bf2f(dst[ci * 8192 + e * 64 + d]);
            }
#pragma unroll
            for (int u = 0; u < 32; ++u) {
                const int c = dir == 0 ? st0 + u : 63 - (st0 + u);
                const size_t ci = (size_t)((gbase + c) * 4 + h) * 2 + dir;
                sp[ci * 8192 + e * 64 + d] = f2bf(s); s = dv[u] * s + xv[u];
            }
        }
    } else {
        const int i2 = it - 512, bs = i2 >> 5, rem = i2 & 31;
        const int h = rem >> 3, dir = (rem >> 2) & 1, eq = rem & 3;
        float dv[4];
        size_t cidx[4];
#pragma unroll
        for (int st = 0; st < 4; ++st) {
            const int c = dir == 0 ? st : 3 - st;
            cidx[st] = (size_t)((bs * 4 + c) * 4 + h) * 2 + dir;
            dv[st] = dec[cidx[st] * 64 + d];
        }
        float xv[8][4];
#pragma unroll
        for (int u = 0; u < 8; ++u)
#pragma unroll
            for (int st = 0; st < 4; ++st) xv[u][st] = bf2f(dst[cidx[st] * 8192 + ((eq * 8 + u) * 4 + wv) * 64 + d]);
#pragma unroll
        for (int u = 0; u < 8; ++u) {
            const int e = (eq * 8 + u) * 4 + wv;
            float s = 0.f;
#pragma unroll
            for (int st = 0; st < 4; ++st) { sp[cidx[st] * 8192 + e * 64 + d] = f2bf(s); s = dv[st] * s + xv[u][st]; }
            p.out[OUT_ST + ((size_t)(((bs * 2 + l) * 2 + dir) * 4 + h)) * 8192 + d * 128 + e] = s;
        }
    }
}

DEV void gla3_item(const Params& p, int l, int it, int tid) {
    char* ws = p.ws;
    const int gch = it >> 2, h = it & 3;
    const int t0 = gch * 64;
    const int lane = tid & 63, wid = __builtin_amdgcn_readfirstlane(tid >> 6), fr = lane & 15, fq = lane >> 4;
    f32x4 acc[8];
    const u32x2* oi = (const u32x2*)(ws + OFF_OI) + ((size_t)it * 4 + wid) * 8 * 64;
#pragma unroll
    for (int n = 0; n < 8; ++n) {
        const u32x2 w = oi[n * 64 + lane];
        acc[n] = (f32x4){__uint_as_float(w.x << 16), __uint_as_float(w.x & 0xffff0000u), __uint_as_float(w.y << 16), __uint_as_float(w.y & 0xffff0000u)};
    }
#pragma unroll
    for (int dir = 0; dir < 2; ++dir) {
        const size_t cc = (size_t)(gch * 4 + h) * 2 + dir;
        const u16* qd = (const u16*)(ws + OFF_QDG) + (size_t)dir * NTOK * 256 + (size_t)(t0 + wid * 16 + fr) * 256 + h * 64;
        const u16* sp = (const u16*)(ws + OFF_SPREV) + cc * 8192;
#pragma unroll
        for (int ks = 0; ks < 2; ++ks) {
            const bf16x8 a = *(const bf16x8*)(qd + ks * 32 + fq * 8);
#pragma unroll
            for (int n = 0; n < 8; ++n) {
                const bf16x8 b = *(const bf16x8*)(sp + (n * 16 + fr) * 64 + ks * 32 + fq * 8);
                acc[n] = mfma16(a, b, acc[n]);
            }
        }
    }
    float gn[8];
#pragma unroll
    for (int n = 0; n < 8; ++n) gn[n] = p.gla_out_norm[l * 128 + n * 16 + fr];
#pragma unroll
    for (int r = 0; r < 4; ++r) {
        float ss = 0.f;
#pragma unroll
        for (int n = 0; n < 8; ++n) ss += acc[n][r] * acc[n][r];
        ss += __shfl_xor(ss, 1); ss += __shfl_xor(ss, 2); ss += __shfl_xor(ss, 4); ss += __shfl_xor(ss, 8);
        const float rstd = rsqrtf(ss * (1.0f / 128.0f) + EPSV);
        const size_t t = (size_t)(t0 + wid * 16 + fq * 4 + r);
        const u16* g = (const u16*)(ws + OFF_LGO) + t * 512 + h * 128;
        u16* o = (u16*)(ws + OFF_GLAOUT) + t * 512 + h * 128;
#pragma unroll
        for (int n = 0; n < 8; ++n) o[n * 16 + fr] = f2bf(acc[n][r] * rstd * gn[n] * bf2f(g[n * 16 + fr]));
    }
}

DEV float diff_lambda_val(const Params& p, int l, int lane) {
    const float* lp = p.diff_lambda + l * 256;
    float a = lp[lane] * lp[64 + lane], b = lp[128 + lane] * lp[192 + lane];
#pragma unroll
    for (int o = 1; o < 64; o <<= 1) { a += __shfl_xor(a, o); b += __shfl_xor(b, o); }
    const float lam_init = l == 0 ? 0.2f : (0.8f - 0.6f * 0.7408182206817179f);
    return __expf(a) - __expf(b) + lam_init;
}

DEV void diffc_item(const Params& p, int l, int it, int tid) {
    char* ws = p.ws;
    const int lane = tid & 63, wid = __builtin_amdgcn_readfirstlane(tid >> 6);
    const float lam = diff_lambda_val(p, l, lane);
    const float lam_init = l == 0 ? 0.2f : (0.8f - 0.6f * 0.7408182206817179f);
    const float g0 = p.diff_sub_norm[l * 128 + 2 * lane] * (1.0f - lam_init), g1 = p.diff_sub_norm[l * 128 + 2 * lane + 1] * (1.0f - lam_init);
    unsigned w1[24], w2[24];
#pragma unroll
    for (int i = 0; i < 24; ++i) {
        const int row = it * 96 + wid * 24 + i;
        const int t = row >> 2, h = row & 3;
        w1[i] = *(const unsigned*)((const u16*)(ws + OFF_DIFFO) + (size_t)t * 1024 + (h * 2) * 128 + 2 * lane);
        w2[i] = *(const unsigned*)((const u16*)(ws + OFF_DIFFO) + (size_t)t * 1024 + (h * 2 + 1) * 128 + 2 * lane);
    }
#pragma unroll
    for (int i = 0; i < 24; ++i) {
        const int row = it * 96 + wid * 24 + i;
        const int t = row >> 2, h = row & 3;
        const float a0 = __uint_as_float(w1[i] << 16) - lam * __uint_as_float(w2[i] << 16);
        const float a1 = __uint_as_float(w1[i] & 0xffff0000u) - lam * __uint_as_float(w2[i] & 0xffff0000u);
        float ss = a0 * a0 + a1 * a1;
#pragma unroll
        for (int o = 1; o < 64; o <<= 1) ss += __shfl_xor(ss, o);
        const float rstd = rsqrtf(ss * (1.0f / 128.0f) + EPSV);
        *(unsigned*)((u16*)(ws + OFF_DIFFOUT) + (size_t)t * 512 + h * 128 + 2 * lane) = pack2(a0 * rstd * g0, a1 * rstd * g1);
    }
}

DEV void p5_tile(const Params& p, int l, int tile, char* lds, int tid) {
    char* ws = p.ws;
    const int xk = tile >> 3, tm = (tile & 7) * 12 + (xk >> 4), tn = xk & 15;
    const int lane = tid & 63, wid = __builtin_amdgcn_readfirstlane(tid >> 6), wr = wid >> 1, wc = wid & 1, fr = lane & 15, fq = lane >> 4;
    f32x4 tot[4][2];
    zero_acc<2>(tot);
    for (int i = 0; i < 3; ++i) {
        f32x4 g[4][2];
        zero_acc<2>(g);
        gemm_mainloop<2, true>(g, (const u16*)(ws + OFF_H) + (size_t)tm * 128 * 1024, 1024, (const u16*)(ws + OFF_WIN) + (size_t)(3968 + i * 1024 + tn * 64) * 1024, 1024, 1024, lds, tid);
#pragma unroll
        for (int m = 0; m < 4; ++m)
#pragma unroll
            for (int n = 0; n < 2; ++n)
#pragma unroll
                for (int j = 0; j < 4; ++j) g[m][n][j] = sigmoidf_(g[m][n][j]);
        f32x4 y[4][2];
        zero_acc<2>(y);
        const u16* bo = (const u16*)(ws + (i == 0 ? OFF_QG : (i == 1 ? OFF_GLAOUT : OFF_DIFFOUT)));
        gemm_mainloop<2, true>(y, bo + (size_t)tm * 128 * 512, 512, (const u16*)(ws + OFF_WBR) + (size_t)(i * 1024 + tn * 64) * 512, 512, 512, lds, tid);
#pragma unroll
        for (int m = 0; m < 4; ++m)
#pragma unroll
            for (int n = 0; n < 2; ++n) tot[m][n] = tot[m][n] + g[m][n] * y[m][n];
    }
    u16* dst = (u16*)(ws + OFF_MIXED) + (size_t)(tm * 128 + wr * 64 + fr) * 1024 + tn * 64 + wc * 32 + fq * 4;
#pragma unroll
    for (int m = 0; m < 4; ++m)
#pragma unroll
        for (int n = 0; n < 2; ++n)
            *(u32x2*)(dst + (size_t)m * 16 * 1024 + n * 16) = (u32x2){pack2(tot[m][n][0], tot[m][n][1]), pack2(tot[m][n][2], tot[m][n][3])};
}

DEV void resid_tile(const Params& p, int l, int which, int tile, char* lds, int tid, int fuse) {
    char* ws = p.ws;
    const int xk = tile >> 3, tm = (tile & 7) * 12 + (xk >> 4), tn = xk & 15;
    const int lane = tid & 63, wid = __builtin_amdgcn_readfirstlane(tid >> 6), wr = wid >> 1, wc = wid & 1, fr = lane & 15, fq = lane >> 4;
    f32x4 acc[4][2];
    zero_acc<2>(acc);
    if (which == 0) gemm_mainloop3<2, true>(acc, (const u16*)(ws + OFF_MIXED) + (size_t)tm * 128 * 1024, 1024, (const u16*)(ws + OFF_WOUT) + (size_t)tn * 64 * 1024, 1024, 1024, lds, tid);
    else gemm_mainloop3<2, true>(acc, (const u16*)(ws + OFF_ACT) + (size_t)tm * 128 * FFH, FFH, (const u16*)(ws + OFF_WFO) + (size_t)tn * 64 * FFH, FFH, FFH, lds, tid);
    const int t0 = tm * 128 + wr * 64;
    const float* gate = (const float*)(ws + OFF_MOD) + (size_t)(l * 3 + tok_cond(t0)) * 6144 + (which == 0 ? 2048 : 5120);
    const int c0 = tn * 64 + wc * 32 + fq * 4;
    float4 gv[2];
    gv[0] = *(const float4*)(gate + c0); gv[1] = *(const float4*)(gate + c0 + 16);
#pragma unroll
    for (int m = 0; m < 4; ++m) {
        const int t = t0 + m * 16 + fr;
        const float* xin;
        if (which == 0 && l == 0) xin = t < 4096 ? p.x_prompt + (size_t)t * 1024 : p.x_sample + (size_t)(t - 4096) * 1024;
        else xin = p.out + (size_t)t * 1024;
        float* xo = p.out + (size_t)t * 1024;
#pragma unroll
        for (int n = 0; n < 2; ++n) {
            const float4 xi = *(const float4*)(xin + c0 + n * 16);
            f32x4 v;
            v[0] = xi.x + gv[n].x * acc[m][n][0]; v[1] = xi.y + gv[n].y * acc[m][n][1]; v[2] = xi.z + gv[n].z * acc[m][n][2]; v[3] = xi.w + gv[n].w * acc[m][n][3];
            float* dst = xo + c0 + n * 16;
            if (fuse >= 0) asm volatile("global_store_dwordx4 %0, %1, off sc1\n\ts_nop 1" :: "v"(dst), "v"(v) : "memory");
            else *(f32x4*)dst = v;
        }
    }
    if (fuse >= 0) {
        volatile LAS unsigned* flag = (volatile LAS unsigned*)(lds + 73728 + 8);
        asm volatile("s_waitcnt vmcnt(0)" ::: "memory");
        __syncthreads();
        if (tid == 0) {
            const unsigned old = __hip_atomic_fetch_add((unsigned*)(ws + OFF_CNT) + fuse * 128 + tm, 1u, __ATOMIC_RELAXED, __HIP_MEMORY_SCOPE_AGENT);
            const unsigned last = (old == 15u) ? 1u : 0u;
            if (last) { __builtin_amdgcn_fence(__ATOMIC_ACQUIRE, "agent"); asm volatile("s_waitcnt vmcnt(0)" ::: "memory"); }
            flag[0] = last;
        }
        __syncthreads();
        const unsigned last = flag[0];
        if (last) {
#pragma unroll 1
            for (int i = 0; i < 4; ++i) {
                if (which == 0) norm_item<8>(p, l, 1, tm * 4 + i, tid);
                else norm_item<8>(p, l + 1, 0, tm * 4 + i, tid);
            }
        }
        __syncthreads();
    }
}

DEV void p8_tile(const Params& p, int l, int tile, char* lds, int tid, int rep = 0) {
    char* ws = p.ws;
    const int tm = tile % 96, tn = tile / 96;
    const int lane = tid & 63, wid = __builtin_amdgcn_readfirstlane(tid >> 6), wr = wid >> 1, wc = wid & 1, fr = lane & 15, fq = lane >> 4;
    f32x4 acc[4][4];
    zero_acc<4>(acc);
    gemm_mainloop<4, true>(acc, (const u16*)(ws + OFF_H) + (size_t)tm * 128 * 1024, 1024, (const u16*)(ws + OFF_WFI) + (size_t)tn * 128 * 1024, 1024, 1024, lds, tid);
    u16* dst = (u16*)(ws + OFF_ACT) + (size_t)(tm * 128 + wr * 64 + fr) * FFH + tn * 64 + wc * 32 + fq * 4;
#pragma unroll
    for (int m = 0; m < 4; ++m)
#pragma unroll
        for (int n = 0; n < 2; ++n) {
            const f32x4 a = acc[m][n], u = acc[m][n + 2];
            *(u32x2*)(dst + (size_t)m * 16 * FFH + n * 16) = (u32x2){pack2(siluf_(a[0]) * u[0], siluf_(a[1]) * u[1]), pack2(siluf_(a[2]) * u[2], siluf_(a[3]) * u[3])};
        }
}

DEV void p5_phase(const Params& p, int l, char* lds) {
    char* ws = p.ws;
    const int nitems = 96 * 16;
    int par = 0; int pre = 0;
    for (int it = blockIdx.x; it < nitems; it += gridDim.x) {
        int tid = threadIdx.x;
        asm volatile("" : "+v"(tid));
        const int lane = tid & 63, wid = __builtin_amdgcn_readfirstlane(tid >> 6), wr = wid >> 1, wc = wid & 1, fr = lane & 15, fq = lane >> 4;
        const int xk = it >> 3, tm = (it & 7) * 12 + (xk >> 4), tn = xk & 15;
        const int nit = it + gridDim.x; const bool hn = nit < nitems;
        const int nxk = nit >> 3, ntm = (nit & 7) * 12 + (nxk >> 4), ntn = nxk & 15;
        const u16* Hp = (const u16*)(ws + OFF_H);
        const u16* Wg = (const u16*)(ws + OFF_WIN) + (size_t)3968 * 1024;
        const u16* Wb = (const u16*)(ws + OFF_WBR);
        f32x4 tot[4][2];
        zero_acc<2>(tot);
#pragma unroll 1
        for (int i = 0; i < 3; ++i) {
            const u16* bo = (const u16*)(ws + (i == 0 ? OFF_QG : (i == 1 ? OFF_GLAOUT : OFF_DIFFOUT)));
            const u16* gA = Hp + (size_t)tm * 128 * 1024, *gB = Wg + (size_t)(i * 1024 + tn * 64) * 1024;
            const u16* yA = bo + (size_t)tm * 128 * 512, *yB = Wb + (size_t)(i * 1024 + tn * 64) * 512;
            f32x4 g[4][2];
            zero_acc<2>(g);
            gemm_chain2<2, true>(g, gA, 1024, gB, 1024, 1024, true, yA, 512, yB, 512, par, pre, lds, tid);
#pragma unroll
            for (int m = 0; m < 4; ++m)
#pragma unroll
                for (int n = 0; n < 2; ++n)
#pragma unroll
                    for (int j = 0; j < 4; ++j) g[m][n][j] = sigmoidf_(g[m][n][j]);
            const bool hx = i < 2 ? true : hn;
            const u16* xA = i < 2 ? gA : Hp + (size_t)ntm * 128 * 1024;
            const u16* xB = i < 2 ? Wg + (size_t)((i + 1) * 1024 + tn * 64) * 1024 : Wg + (size_t)(ntn * 64) * 1024;
            f32x4 y[4][2];
            zero_acc<2>(y);
            gemm_chain2<2, true>(y, yA, 512, yB, 512, 512, hx, xA, 1024, xB, 1024, par, pre, lds, tid);
#pragma unroll
            for (int m = 0; m < 4; ++m)
#pragma unroll
                for (int n = 0; n < 2; ++n) tot[m][n] = tot[m][n] + g[m][n] * y[m][n];
        }
        u16* dst = (u16*)(ws + OFF_MIXED) + (size_t)(tm * 128 + wr * 64 + fr) * 1024 + tn * 64 + wc * 32 + fq * 4;
#pragma unroll
        for (int m = 0; m < 4; ++m)
#pragma unroll
            for (int n = 0; n < 2; ++n)
                *(u32x2*)(dst + (size_t)m * 16 * 1024 + n * 16) = (u32x2){pack2(tot[m][n][0], tot[m][n][1]), pack2(tot[m][n][2], tot[m][n][3])};
    }
}

DEV void p8_phase(const Params& p, int l, char* lds) {
    char* ws = p.ws;
    const int nitems = 96 * 44;
    int par = 0; int pre = 0;
    for (int it = blockIdx.x; it < nitems; it += gridDim.x) {
        int tid = threadIdx.x;
        asm volatile("" : "+v"(tid));
        const int lane = tid & 63, wid = __builtin_amdgcn_readfirstlane(tid >> 6), wr = wid >> 1, wc = wid & 1, fr = lane & 15, fq = lane >> 4;
        const int tm = it % 96, tn = it / 96;
        const int nit = it + gridDim.x; const bool hn = nit < nitems;
        const int ntm = nit % 96, ntn = nit / 96;
        f32x4 acc[4][4];
        zero_acc<4>(acc);
        gemm_chain2<4, true>(acc, (const u16*)(ws + OFF_H) + (size_t)tm * 128 * 1024, 1024, (const u16*)(ws + OFF_WFI) + (size_t)tn * 128 * 1024, 1024, 1024,
                            hn, (const u16*)(ws + OFF_H) + (size_t)ntm * 128 * 1024, 1024, (const u16*)(ws + OFF_WFI) + (size_t)ntn * 128 * 1024, 1024, par, pre, lds, tid);
        u16* dst = (u16*)(ws + OFF_ACT) + (size_t)(tm * 128 + wr * 64 + fr) * FFH + tn * 64 + wc * 32 + fq * 4;
#pragma unroll
        for (int m = 0; m < 4; ++m)
#pragma unroll
            for (int n = 0; n < 2; ++n) {
                const f32x4 a = acc[m][n], u = acc[m][n + 2];
                *(u32x2*)(dst + (size_t)m * 16 * FFH + n * 16) = (u32x2){pack2(siluf_(a[0]) * u[0], siluf_(a[1]) * u[1]), pack2(siluf_(a[2]) * u[2], siluf_(a[3]) * u[3])};
            }
    }
}

DEV void p2_phase(const Params& p, int l, char* lds) {
    char* ws = p.ws;
    for (int it = blockIdx.x; it < 1024; it += gridDim.x) {
        int tid = threadIdx.x;
        asm volatile("" : "+v"(tid));
        if (it < 512) {
            const int j = it & 7, r = it >> 3, b = j >> 2, hm = (j & 3) * 2 + (r >> 5), qb = r & 31, bs = 16 + b;
            attn_item<128>((const u16*)(ws + OFF_QD), hm * 64, 4096 + b * 4096 + qb * 128, kd_ptr(ws, bs, hm), vdt_ptr(ws, bs, hm >> 1), 4608, (u16*)(ws + OFF_DIFFO), 1024, hm * 128, lds, tid);
        } else {
            const int i2 = it - 512, j = i2 & 7, r = i2 >> 3, b = j >> 2, kvh = (j >> 1) & 1, hh = kvh * 4 + (j & 1) * 2 + (r >> 5), qb = r & 31, bs = 16 + b;
            attn_item<64>((const u16*)(ws + OFF_QG), hh * 64, 4096 + b * 4096 + qb * 128, kg_ptr(ws, bs, hh >> 2), vgt_ptr(ws, bs, hh >> 2), 4608, (u16*)(ws + OFF_QG), 512, hh * 64, lds, tid);
        }
    }
    volatile LAS unsigned* flag = (volatile LAS unsigned*)(lds + 73728 + 8);
    unsigned* cnt = (unsigned*)(ws + OFF_CNT) + l * 64;
    for (;;) {
        int tid = threadIdx.x;
        asm volatile("" : "+v"(tid));
        __syncthreads();
        if (tid == 0) flag[0] = __hip_atomic_fetch_add(cnt, 1u, __ATOMIC_RELAXED, __HIP_MEMORY_SCOPE_AGENT);
        __syncthreads();
        const int j = __builtin_amdgcn_readfirstlane((int)flag[0]);
        if (j >= 1280) break;
        if (j < 768) gla1_item(p, l, j, lds, tid);
        else {
            const int i2 = j - 768, bs = i2 >> 5, ty = (i2 >> 4) & 1, hh = (i2 >> 1) & 7, qb = i2 & 1;
            if (ty == 0) attn_item<128>((const u16*)(ws + OFF_QD), hh * 64, bs * 256 + qb * 128, kd_ptr(ws, bs, hh), vdt_ptr(ws, bs, hh >> 1), 256, (u16*)(ws + OFF_DIFFO), 1024, hh * 128, lds, tid);
            else attn_item<64>((const u16*)(ws + OFF_QG), hh * 64, bs * 256 + qb * 128, kg_ptr(ws, bs, hh >> 2), vgt_ptr(ws, bs, hh >> 2), 256, (u16*)(ws + OFF_QG), 512, hh * 64, lds, tid);
        }
    }
}

#define XB_TMO      128
#define XB_XCNT(j)  (256  + 64 * (j))
#define XB_XSUB(j)  (1280 + 64 * (j))
#define XB_XGEN(j)  (2304 + 64 * (j))
#define XB_TOP      3328
#define XB_TOPGEN   3392
#define XCD_BAR_WORDS 3456
#define XB_SPIN_CAP (1u << 22)
DEV unsigned xb_ld(unsigned* p) { return __hip_atomic_load(p, __ATOMIC_RELAXED, __HIP_MEMORY_SCOPE_AGENT); }
DEV unsigned xb_add(unsigned* p, unsigned v) { return __hip_atomic_fetch_add(p, v, __ATOMIC_RELAXED, __HIP_MEMORY_SCOPE_AGENT); }
DEV unsigned xb_xcc_id() { return (unsigned)__builtin_amdgcn_s_getreg((3 << 11) | 20) & 0xFu; }
#define XB_SPIN(cond, bar) do { unsigned _sp = 0; while (cond) { __builtin_amdgcn_s_sleep(1); \
    if ((++_sp & 255u) == 0u) { if (xb_ld(&(bar)[XB_TMO])) break; if (_sp > XB_SPIN_CAP) { atomicAdd(&(bar)[XB_TMO], 1u); break; } } } } while (0)
struct XcdBarrier { unsigned* bar; unsigned x; volatile LAS unsigned* st; };
DEV XcdBarrier xcd_barrier_post(unsigned* bar, volatile LAS unsigned* st) {
    XcdBarrier b; b.bar = bar; b.x = xb_xcc_id(); b.st = st;
    if (threadIdx.x == 0) (void)xb_add(&bar[XB_XCNT(b.x)], 1u);
    return b;
}
DEV void xcd_barrier_complete(unsigned* bar, unsigned x, unsigned& nloc, unsigned& nx) {
    const unsigned G = gridDim.x * gridDim.y * gridDim.z;
    unsigned sum, cnt, mine, sp = 0u;
    for (;;) {
        sum = 0u; cnt = 0u; mine = 0u;
#pragma unroll
        for (unsigned j = 0; j < 16; ++j) { const unsigned c = xb_ld(&bar[XB_XCNT(j)]); sum += c; cnt += (c > 0u) ? 1u : 0u; mine = (j == x) ? c : mine; }
        if (sum == G) break;
        __builtin_amdgcn_s_sleep(1);
        if ((++sp & 255u) == 0u) { if (xb_ld(&bar[XB_TMO])) break; if (sp > XB_SPIN_CAP) { atomicAdd(&bar[XB_TMO], 1u); break; } }
    }
    nloc = mine > 0u ? mine : 1u; nx = cnt > 0u ? cnt : 1u;
}
DEV void xcd_barrier(const XcdBarrier& b) {
    asm volatile("s_waitcnt vmcnt(0)" ::: "memory");
    __syncthreads();
    if (threadIdx.x == 0) {
        unsigned* bar = b.bar;
        __builtin_amdgcn_s_waitcnt(0);
        unsigned nloc = b.st[0], nx = b.st[1];
        if (nloc == 0u) { xcd_barrier_complete(bar, b.x, nloc, nx); b.st[0] = nloc; b.st[1] = nx; }
        const unsigned old = xb_add(&bar[XB_XSUB(b.x)], 1u);
        const unsigned gen = old / nloc;
        if (old + 1u == (gen + 1u) * nloc) {
            __builtin_amdgcn_fence(__ATOMIC_RELEASE, "agent");
            asm volatile("s_waitcnt vmcnt(0)" ::: "memory");
            const unsigned og = xb_add(&bar[XB_TOP], 1u);
            const unsigned tg = og / nx;
            if (og + 1u == (tg + 1u) * nx) xb_add(&bar[XB_TOPGEN], 1u);
            else XB_SPIN(xb_ld(&bar[XB_TOPGEN]) == tg, bar);
            __builtin_amdgcn_fence(__ATOMIC_ACQUIRE, "agent");
            xb_add(&bar[XB_XGEN(b.x)], 1u);
            asm volatile("s_waitcnt vmcnt(0)" ::: "memory");
        } else {
            XB_SPIN(xb_ld(&bar[XB_XGEN(b.x)]) == gen, bar);
            __builtin_amdgcn_fence(__ATOMIC_ACQUIRE, "agent");
            asm volatile("s_waitcnt vmcnt(0)" ::: "memory");
        }
    }
    __syncthreads();
}

constexpr int NPHASE = 21;
__host__ __device__ inline int phase_items(int ph) {
    if (ph == 0) return NCONV + NMOD + 1 + NCACHE;
    const int l = (ph - 1) / 10, k = (ph - 1) % 10;
    switch (k) {
        case 0: return 384 + (l == 1 ? NCONV + NCACHE : 0);
        case 1: return 96 * 31;
        case 2: return 512 + 512 + 512 + 768;
        case 3: return 512 + 512;
        case 4: return 768 + 768;
        case 5: return 96 * 16;
        case 6: return 96 * 16;
        case 7: return 384;
        case 8: return 96 * 44;
        default: return 96 * 16;
    }
}

DEV void run_phase(const Params& p, int ph, char* lds, int rep = 0) {
    const int nitems = phase_items(ph);
    char* ws = p.ws;
    if (ph == 0) {
        for (int it = blockIdx.x; it < nitems; it += gridDim.x) {
            int tid = threadIdx.x;
            asm volatile("" : "+v"(tid));
            if (it < NCONV) conv_item(p, 0, it, lds, tid);
            else if (it < NCONV + NMOD) mod_item(p, it - NCONV, lds, tid);
            else if (it == NCONV + NMOD) rope_item(p, tid);
            else cache_item(p, 0, it - (NCONV + NMOD + 1), tid);
        }
        return;
    }
    const int l = (ph - 1) / 10, k = (ph - 1) % 10;
    if (k == 2) { p2_phase(p, l, lds); return; }
    if (k == 5) { p5_phase(p, l, lds); return; }
    if (k == 8) { p8_phase(p, l, lds); return; }
    for (int it = blockIdx.x; it < nitems; it += gridDim.x) {
        int tid = threadIdx.x;
        asm volatile("" : "+v"(tid));
        switch (k) {
            case 0:
                if (it < 384) norm_item<8>(p, l, 0, it, tid);
                else if (it < 384 + NCONV) conv_item(p, 1, it - 384, lds, tid);
                else cache_item(p, 1, it - 384 - NCONV, tid);
                break;
            case 1: p1_tile(p, l, it, lds, tid); break;
            case 2: {
                if (rep && ((it >= 512 && it < 1024) || (it >= 1024 && it < 1536 && ((it >> 4) & 1)))) break;
                if (it < 512) {
                    const int j = it & 7, r = it >> 3, b = j >> 2, hm = (j & 3) * 2 + (r >> 5), qb = r & 31, bs = 16 + b;
                    attn_item<128>((const u16*)(ws + OFF_QD), hm * 64, 4096 + b * 4096 + qb * 128, kd_ptr(ws, bs, hm), vdt_ptr(ws, bs, hm >> 1), 4608, (u16*)(ws + OFF_DIFFO), 1024, hm * 128, lds, tid);
                } else if (it < 1024) {
                    const int i2 = it - 512, j = i2 & 7, r = i2 >> 3, b = j >> 2, kvh = (j >> 1) & 1, hh = kvh * 4 + (j & 1) * 2 + (r >> 5), qb = r & 31, bs = 16 + b;
                    attn_item<64>((const u16*)(ws + OFF_QG), hh * 64, 4096 + b * 4096 + qb * 128, kg_ptr(ws, bs, hh >> 2), vgt_ptr(ws, bs, hh >> 2), 4608, (u16*)(ws + OFF_QG), 512, hh * 64, lds, tid);
                } else if (it < 1536) {
                    const int i2 = it - 1024, bs = i2 >> 5, ty = (i2 >> 4) & 1, hh = (i2 >> 1) & 7, qb = i2 & 1;
                    if (ty == 0) attn_item<128>((const u16*)(ws + OFF_QD), hh * 64, bs * 256 + qb * 128, kd_ptr(ws, bs, hh), vdt_ptr(ws, bs, hh >> 1), 256, (u16*)(ws + OFF_DIFFO), 1024, hh * 128, lds, tid);
                    else attn_item<64>((const u16*)(ws + OFF_QG), hh * 64, bs * 256 + qb * 128, kg_ptr(ws, bs, hh >> 2), vgt_ptr(ws, bs, hh >> 2), 256, (u16*)(ws + OFF_QG), 512, hh * 64, lds, tid);
                } else gla1_item(p, l, it - 1536, lds, tid);
                break;
            }
            case 3: scan_item(p, l, it, tid); break;
            case 4:
                if (it < 768) gla3_item(p, l, it, tid);
                else { const int j = it - 768, di = j < 256 ? j : (j >= 512 ? j - 256 : -1); if (di >= 0) diffc_item(p, l, di, tid); }
                break;
            case 5: p5_tile(p, l, it, lds, tid); break;
            case 6: resid_tile(p, l, 0, it, lds, tid, -1); break;
            case 7: norm_item<8>(p, l, 1, it, tid); break;
            case 8: p8_tile(p, l, it, lds, tid); break;
            default: resid_tile(p, l, 1, it, lds, tid, -1); break;
        }
    }
}

__global__ void __launch_bounds__(256, 2) fwd_kernel(Params p) {
    __shared__ __attribute__((aligned(16))) char lds[73728 + 16];
#ifdef ONE_LAUNCH
    volatile LAS unsigned* st = (volatile LAS unsigned*)(lds + 73728);
    if (threadIdx.x == 0) { st[0] = 0u; st[1] = 0u; }
    __syncthreads();
    XcdBarrier xb = xcd_barrier_post((unsigned*)(p.ws + OFF_BAR), st);
    if (p.pad0 == 0x7fffffff) cg::this_grid().sync();
#endif
    for (int ph = p.phase_lo; ph <= p.phase_hi; ++ph) {
        if (phase_items(ph) == 0) continue;
#ifdef PROBE_REP
        if (ph > 0 && ((PROBE_REP >> ((ph - 1) % 10)) & 1)) { run_phase(p, ph, lds, 1); xcd_barrier(xb); }
#endif
        run_phase(p, ph, lds);
#ifdef ONE_LAUNCH
        if (ph < p.phase_hi) xcd_barrier(xb);
#endif
    }
}

extern "C" void kernel_launch(void* const* d_in, const int* in_sizes, int n_in, void* d_out, int out_size, void* d_ws, size_t ws_size, hipStream_t stream) {
    Params p{};
    const float** f = (const float**)&p;
    for (int i = 0; i < 27; ++i) f[i] = (const float*)d_in[i];
    p.out = (float*)d_out;
    p.ws = (char*)d_ws;
    if (ws_size < WS_END) { fprintf(stderr, "workspace too small: %zu < %zu\n", ws_size, (size_t)WS_END); return; }
#ifndef ONE_LAUNCH
    for (int ph = 0; ph < NPHASE; ++ph) {
        Params q = p;
        q.phase_lo = ph; q.phase_hi = ph;
        int g = phase_items(ph);
        if (g > 2048) g = 2048;
        hipLaunchKernelGGL(fwd_kernel, dim3(g), dim3(256), 0, stream, q);
    }
#else
    static int grid_blocks = 0;
    if (!grid_blocks) {
        int dev = 0, cus = 0, per_cu = 0;
        hipGetDevice(&dev);
        hipDeviceGetAttribute(&cus, hipDeviceAttributeMultiprocessorCount, dev);
        hipOccupancyMaxActiveBlocksPerMultiprocessor(&per_cu, fwd_kernel, 256, 0);
        if (per_cu > 2) per_cu = 2;
        grid_blocks = cus * per_cu;
    }
    p.phase_lo = 0; p.phase_hi = NPHASE - 1;
    hipMemsetAsync((char*)d_ws + OFF_BAR, 0, (size_t)(OFF_CNT - OFF_BAR) + (size_t)3 * 128 * 4, stream);
    void* args[] = {&p};
    hipError_t e = hipLaunchCooperativeKernel((void*)fwd_kernel, dim3(grid_blocks), dim3(256), args, 0, stream);
    if (e != hipSuccess) fprintf(stderr, "cooperative launch failed: %s (grid %d)\n", hipGetErrorString(e), grid_blocks);
#endif
}
```

```cpp
#define ONE_LAUNCH 1
#include <hip/hip_runtime.h>
#include <hip/hip_cooperative_groups.h>
#include <cstdio>
#include <cstdint>
namespace cg = cooperative_groups;

#define DEV __device__ __forceinline__
typedef unsigned short u16;
typedef short bf16x8 __attribute__((ext_vector_type(8)));
typedef float f32x4 __attribute__((ext_vector_type(4)));
typedef unsigned u32x4 __attribute__((ext_vector_type(4)));
typedef unsigned u32x2 __attribute__((ext_vector_type(2)));
#define LAS __attribute__((address_space(3)))

constexpr int NTOK = 12288;
constexpr int DM = 1024;
constexpr int NIN_SRC = 6944;
constexpr int NWIN = 7040;
constexpr int FFH = 2816;
constexpr float EPSV = 1e-6f;
constexpr float QSCALE = 0.125f * 1.4426950408889634f;

constexpr size_t al256(size_t x) { return (x + 255) & ~(size_t)255; }
constexpr size_t OFF_WIN = 0;
constexpr size_t OFF_WBR = OFF_WIN + al256((size_t)NWIN * 1024 * 2);
constexpr size_t OFF_WOUT = OFF_WBR + al256((size_t)3 * 1024 * 512 * 2);
constexpr size_t OFF_WFI = OFF_WOUT + al256((size_t)1024 * 1024 * 2);
constexpr size_t OFF_WFO = OFF_WFI + al256((size_t)5632 * 1024 * 2);
constexpr size_t OFF_MOD = OFF_WFO + al256((size_t)1024 * 2816 * 2);
constexpr size_t OFF_ROPE = OFF_MOD + al256((size_t)2 * 3 * 6144 * 4);
constexpr size_t OFF_H = OFF_ROPE + al256((size_t)64 * 16 * 2 * 4);
constexpr size_t OFF_QG = OFF_H + al256((size_t)NTOK * 1024 * 2);
constexpr size_t OFF_QD = OFF_QG + al256((size_t)NTOK * 512 * 2);
constexpr size_t OFF_KGC = OFF_QD + al256((size_t)NTOK * 512 * 2);
constexpr size_t OFF_VGC = OFF_KGC + al256((size_t)16 * 2 * 256 * 64 * 2);
constexpr size_t OFF_KDC = OFF_VGC + al256((size_t)16 * 2 * 256 * 64 * 2);
constexpr size_t OFF_VDC = OFF_KDC + al256((size_t)16 * 8 * 256 * 64 * 2);
constexpr size_t OFF_KGL = OFF_VDC + al256((size_t)16 * 4 * 128 * 256 * 2);
constexpr size_t OFF_VGL = OFF_KGL + al256((size_t)2 * 2 * 4608 * 64 * 2);
constexpr size_t OFF_KDL = OFF_VGL + al256((size_t)2 * 2 * 4608 * 64 * 2);
constexpr size_t OFF_VDL = OFF_KDL + al256((size_t)2 * 8 * 4608 * 64 * 2);
constexpr size_t OFF_LQ = OFF_VDL + al256((size_t)2 * 4 * 128 * 4608 * 2);
constexpr size_t OFF_LK = OFF_LQ + al256((size_t)NTOK * 256 * 2);
constexpr size_t OFF_LVT = OFF_LK + al256((size_t)NTOK * 256 * 2);
constexpr size_t OFF_LGO = OFF_LVT + al256((size_t)NTOK * 512 * 2);
constexpr size_t OFF_LR = OFF_LGO + al256((size_t)NTOK * 512 * 2);
constexpr size_t OFF_DIFFO = OFF_LR + al256((size_t)NTOK * 32 * 4);
constexpr size_t OFF_QDG = OFF_DIFFO + al256((size_t)NTOK * 1024 * 2);
constexpr size_t OFF_OI = OFF_QDG + al256((size_t)2 * NTOK * 256 * 2);
constexpr size_t OFF_DST = OFF_OI + al256((size_t)768 * 4 * 8 * 64 * 8);
constexpr size_t OFF_DECAY = OFF_DST + al256((size_t)1536 * 8192 * 2);
constexpr size_t OFF_BAR = OFF_DECAY + al256((size_t)1536 * 64 * 4);
constexpr size_t OFF_CNT = OFF_BAR + al256((size_t)3456 * 4);
constexpr size_t OFF_XB = OFF_CNT + al256((size_t)3 * 128 * 4);
constexpr size_t WS_END = OFF_XB + al256((size_t)NTOK * 1024 * 2);
constexpr size_t OFF_SPREV = OFF_KGC;
constexpr size_t OFF_MIXED = OFF_KGC;
constexpr size_t OFF_GLAOUT = OFF_LQ;
constexpr size_t OFF_DIFFOUT = OFF_LVT;
constexpr size_t OFF_ACT = OFF_DIFFO;
static_assert(OFF_LQ - OFF_KGC >= (size_t)NTOK * 1024 * 2, "alias");
static_assert(OFF_DECAY - OFF_DIFFO >= (size_t)NTOK * 2816 * 2, "alias");
static_assert(WS_END <= (size_t)256 * 1024 * 1024, "ws");

constexpr size_t OUT_GK = 12582912, OUT_GV = 13631488, OUT_ST = 14680064, OUT_DK = 16777216, OUT_DV = 20971520;

struct Params {
    const float *x_prompt, *x_sample, *c, *cache_gqa_k, *cache_gqa_v, *state_gla, *cache_diff_k, *cache_diff_v, *c_ctx,
        *w_mod, *b_mod, *norm1, *norm2, *w_in, *gqa_q_norm, *gqa_k_norm, *gla_alpha_up, *gla_alpha_bias, *gla_out_norm,
        *diff_q_norm, *diff_k_norm, *diff_lambda, *diff_sub_norm, *w_branch, *w_out, *w_ffn_in, *w_ffn_out;
    float* out;
    char* ws;
    int phase_lo, phase_hi, pad0, pad1;
};

typedef __bf16 bf16x2_t __attribute__((ext_vector_type(2)));
typedef float f32x2_t __attribute__((ext_vector_type(2)));
DEV u16 f2bf(float f) { const __bf16 b = (__bf16)f; return __builtin_bit_cast(u16, b); }
DEV float bf2f(u16 h) { return __uint_as_float(((unsigned)h) << 16); }
DEV unsigned pack2(float lo, float hi) { const f32x2_t v = {lo, hi}; const bf16x2_t b = __builtin_convertvector(v, bf16x2_t); return __builtin_bit_cast(unsigned, b); }
DEV float sigmoidf_(float x) { return 1.0f / (1.0f + __expf(-x)); }
DEV float siluf_(float x) { return x / (1.0f + __expf(-x)); }
DEV int tok_cond(int t) { return t < 4096 ? 0 : 1 + ((t - 4096) >> 12); }
DEV int tok_bs(int t) { return t < 4096 ? (t >> 8) : 16 + ((t - 4096) >> 12); }
DEV int tok_n(int t) { return t < 4096 ? (t & 255) : ((t - 4096) & 4095); }
DEV f32x4 mfma16(bf16x8 a, bf16x8 b, f32x4 c) { return __builtin_amdgcn_mfma_f32_16x16x32_bf16(a, b, c, 0, 0, 0); }

DEV u16* kg_ptr(char* ws, int bs, int kv) { return bs < 16 ? (u16*)(ws + OFF_KGC) + (size_t)((bs * 2 + kv) * 256) * 64 : (u16*)(ws + OFF_KGL) + (size_t)(((bs - 16) * 2 + kv) * 4608) * 64; }
DEV u16* vgt_ptr(char* ws, int bs, int kv) { return bs < 16 ? (u16*)(ws + OFF_VGC) + (size_t)((bs * 2 + kv) * 64) * 256 : (u16*)(ws + OFF_VGL) + (size_t)(((bs - 16) * 2 + kv) * 64) * 4608; }
DEV u16* kd_ptr(char* ws, int bs, int hm) { return bs < 16 ? (u16*)(ws + OFF_KDC) + (size_t)((bs * 8 + hm) * 256) * 64 : (u16*)(ws + OFF_KDL) + (size_t)(((bs - 16) * 8 + hm) * 4608) * 64; }
DEV u16* vdt_ptr(char* ws, int bs, int h) { return bs < 16 ? (u16*)(ws + OFF_VDC) + (size_t)((bs * 4 + h) * 128) * 256 : (u16*)(ws + OFF_VDL) + (size_t)(((bs - 16) * 4 + h) * 128) * 4608; }
DEV u16* lvt_ptr(char* ws, int bs, int h) { return bs < 16 ? (u16*)(ws + OFF_LVT) + (size_t)((bs * 4 + h) * 128) * 256 : (u16*)(ws + OFF_LVT) + (size_t)2097152 + (size_t)(((bs - 16) * 4 + h) * 128) * 4096; }

template <int ROWS, int SW = 0>
DEV void stage_rows(const u16* g, unsigned ld, char* lds, int tid) {
    const int wbase = __builtin_amdgcn_readfirstlane(tid >> 6) * 64;
    const char* gb = (const char*)g;
#pragma unroll
    for (int i = 0; i < ROWS / 32; ++i) {
        const int idx = tid + i * 256;
        const int r = idx >> 3, s = idx & 7;
        const int c = s ^ (SW == 0 ? (r & 7) : ((r >> 1) & 7));
        const unsigned off = ((unsigned)r * ld + (unsigned)c * 8u) * 2u;
        __builtin_amdgcn_global_load_lds((const void*)(gb + off), (LAS void*)(lds + (wbase + i * 256) * 16), 16, 0, 0);
    }
}
DEV bf16x8 lds_frag(const char* tile, int row, int chunk) { return *(const bf16x8*)(tile + row * 128 + ((chunk ^ (row & 7)) << 4)); }
DEV bf16x8 lds_frag1(const char* tile, int row, int chunk) { return *(const bf16x8*)(tile + row * 128 + ((chunk ^ ((row >> 1) & 7)) << 4)); }
typedef float f32x16 __attribute__((ext_vector_type(16)));
DEV f32x16 mfma32(bf16x8 a, bf16x8 b, f32x16 c) { return __builtin_amdgcn_mfma_f32_32x32x16_bf16(a, b, c, 0, 0, 0); }
DEV void wait_vm0() { asm volatile("s_waitcnt vmcnt(0)" ::: "memory"); }

template <int NT, bool TR = false>
DEV void gemm_mainloop(f32x4 (&acc)[4][NT], const u16* A, unsigned lda, const u16* B, unsigned ldb, int K, char* lds, int tid) {
    constexpr int BN = NT * 32;
    constexpr int AB = 128 * 128, BB = BN * 128, STG = AB + BB;
    const int lane = tid & 63, wid = __builtin_amdgcn_readfirstlane(tid >> 6), wr = wid >> 1, wc = wid & 1, fr = lane & 15, fq = lane >> 4;
    const int nk = K >> 6;
    stage_rows<128>(A, lda, lds, tid);
    stage_rows<BN>(B, ldb, lds + AB, tid);
    for (int kt = 0; kt < nk; ++kt) {
        char* cur = lds + (kt & 1) * STG;
        wait_vm0();
        __syncthreads();
        if (kt + 1 < nk) {
            char* nxt = lds + ((kt + 1) & 1) * STG;
            stage_rows<128>(A + (size_t)(kt + 1) * 64, lda, nxt, tid);
            stage_rows<BN>(B + (size_t)(kt + 1) * 64, ldb, nxt + AB, tid);
        }
        {
            bf16x8 a[2][4], b[2][NT];
#pragma unroll
            for (int ks = 0; ks < 2; ++ks) {
#pragma unroll
                for (int m = 0; m < 4; ++m) a[ks][m] = lds_frag(cur, wr * 64 + m * 16 + fr, ks * 4 + fq);
#pragma unroll
                for (int n = 0; n < NT; ++n) b[ks][n] = lds_frag(cur + AB, wc * (NT * 16) + n * 16 + fr, ks * 4 + fq);
            }
            __builtin_amdgcn_sched_barrier(0);
#pragma unroll
            for (int ks = 0; ks < 2; ++ks)
#pragma unroll
                for (int m = 0; m < 4; ++m)
#pragma unroll
                    for (int n = 0; n < NT; ++n) acc[m][n] = TR ? mfma16(b[ks][n], a[ks][m], acc[m][n]) : mfma16(a[ks][m], b[ks][n], acc[m][n]);
        }
    }
    __syncthreads();
}

template <int NT>
DEV void zero_acc(f32x4 (&acc)[4][NT]) {
#pragma unroll
    for (int m = 0; m < 4; ++m)
#pragma unroll
        for (int n = 0; n < NT; ++n) acc[m][n] = (f32x4){0.f, 0.f, 0.f, 0.f};
}

template <int NT, bool TR>
DEV void gemm_chain(f32x4 (&acc)[4][NT], const u16* A, unsigned lda, const u16* B, unsigned ldb, int K,
                    bool has_next, const u16* nA, unsigned nlda, const u16* nB, unsigned nldb, int& par, bool& pre, char* lds, int tid) {
    constexpr int BN = NT * 32;
    constexpr int AB = 128 * 128, BB = BN * 128, STG = AB + BB;
    const int lane = tid & 63, wid = __builtin_amdgcn_readfirstlane(tid >> 6), wr = wid >> 1, wc = wid & 1, fr = lane & 15, fq = lane >> 4;
    const int nk = K >> 6;
    if (!pre) {
        stage_rows<128>(A, lda, lds + par * STG, tid);
        stage_rows<BN>(B, ldb, lds + par * STG + AB, tid);
    }
    for (int kt = 0; kt < nk; ++kt) {
        char* cur = lds + ((par + kt) & 1) * STG;
        char* nxt = lds + ((par + kt + 1) & 1) * STG;
        wait_vm0();
        __syncthreads();
        if (kt + 1 < nk) {
            stage_rows<128>(A + (size_t)(kt + 1) * 64, lda, nxt, tid);
            stage_rows<BN>(B + (size_t)(kt + 1) * 64, ldb, nxt + AB, tid);
        } else if (has_next) {
            stage_rows<128>(nA, nlda, nxt, tid);
            stage_rows<BN>(nB, nldb, nxt + AB, tid);
        }
        {
            bf16x8 a[2][4], b[2][NT];
#pragma unroll
            for (int ks = 0; ks < 2; ++ks) {
#pragma unroll
                for (int m = 0; m < 4; ++m) a[ks][m] = lds_frag(cur, wr * 64 + m * 16 + fr, ks * 4 + fq);
#pragma unroll
                for (int n = 0; n < NT; ++n) b[ks][n] = lds_frag(cur + AB, wc * (NT * 16) + n * 16 + fr, ks * 4 + fq);
            }
            __builtin_amdgcn_sched_barrier(0);
#pragma unroll
            for (int ks = 0; ks < 2; ++ks)
#pragma unroll
                for (int m = 0; m < 4; ++m)
#pragma unroll
                    for (int n = 0; n < NT; ++n) acc[m][n] = TR ? mfma16(b[ks][n], a[ks][m], acc[m][n]) : mfma16(a[ks][m], b[ks][n], acc[m][n]);
        }
    }
    par = (par + nk) & 1;
    pre = has_next;
    if (!has_next) __syncthreads();
}

template <int NT, bool TR>
DEV void gemm_chain2(f32x4 (&acc)[4][NT], const u16* A, unsigned lda, const u16* B, unsigned ldb, int K,
                     bool has_next, const u16* nA, unsigned nlda, const u16* nB, unsigned nldb, int& par, int& pre, char* lds, int tid) {
    constexpr int BN = NT * 32;
    constexpr int AB = 128 * 128, BB = BN * 128, STG = AB + BB;
    static_assert(NT == 2 || NT == 4, "vmcnt literals");
    const int lane = tid & 63, wid = __builtin_amdgcn_readfirstlane(tid >> 6), wr = wid >> 1, wc = wid & 1, fr = lane & 15, fq = lane >> 4;
    const int nk = K >> 6;
    if (pre < 1) { stage_rows<128>(A, lda, lds + par * STG, tid); stage_rows<BN>(B, ldb, lds + par * STG + AB, tid); }
    if (pre < 2) { stage_rows<128>(A + 64, lda, lds + (par ^ 1) * STG, tid); stage_rows<BN>(B + 64, ldb, lds + (par ^ 1) * STG + AB, tid); }
    for (int kt = 0; kt < nk; ++kt) {
        char* cur = lds + ((par + kt) & 1) * STG;
        const bool younger = (kt + 1 < nk) || has_next;
        if (kt == 0 || !younger) asm volatile("s_waitcnt vmcnt(0)" ::: "memory");
        else if (NT == 4) asm volatile("s_waitcnt vmcnt(8)" ::: "memory");
        else asm volatile("s_waitcnt vmcnt(6)" ::: "memory");
        __builtin_amdgcn_s_barrier();
        asm volatile("" ::: "memory");
        bf16x8 a[2][4], b[2][NT];
#pragma unroll
        for (int ks = 0; ks < 2; ++ks) {
#pragma unroll
            for (int m = 0; m < 4; ++m) a[ks][m] = lds_frag(cur, wr * 64 + m * 16 + fr, ks * 4 + fq);
#pragma unroll
            for (int n = 0; n < NT; ++n) b[ks][n] = lds_frag(cur + AB, wc * (NT * 16) + n * 16 + fr, ks * 4 + fq);
        }
        asm volatile("s_waitcnt lgkmcnt(0)" ::: "memory");
        __builtin_amdgcn_s_barrier();
        asm volatile("" ::: "memory");
        if (kt + 2 < nk) {
            stage_rows<128>(A + (size_t)(kt + 2) * 64, lda, cur, tid);
            stage_rows<BN>(B + (size_t)(kt + 2) * 64, ldb, cur + AB, tid);
        } else if (has_next) {
            const int j = kt + 2 - nk;
            stage_rows<128>(nA + (size_t)j * 64, nlda, cur, tid);
            stage_rows<BN>(nB + (size_t)j * 64, nldb, cur + AB, tid);
        }
        __builtin_amdgcn_sched_barrier(0);
#pragma unroll
        for (int ks = 0; ks < 2; ++ks)
#pragma unroll
            for (int m = 0; m < 4; ++m)
#pragma unroll
                for (int n = 0; n < NT; ++n) acc[m][n] = TR ? mfma16(b[ks][n], a[ks][m], acc[m][n]) : mfma16(a[ks][m], b[ks][n], acc[m][n]);
    }
    par = (par + nk) & 1;
    pre = has_next ? 2 : 0;
    if (!has_next) __syncthreads();
}

template <int NT, bool TR = false>
DEV void gemm_mainloop3(f32x4 (&acc)[4][NT], const u16* A, unsigned lda, const u16* B, unsigned ldb, int K, char* lds, int tid) {
    constexpr int BN = NT * 32;
    constexpr int AB = 128 * 128, BB = BN * 128, STG = AB + BB;
    static_assert(NT == 2, "vmcnt literal below assumes 6 DMA pieces per thread per tile");
    const int lane = tid & 63, wid = __builtin_amdgcn_readfirstlane(tid >> 6), wr = wid >> 1, wc = wid & 1, fr = lane & 15, fq = lane >> 4;
    const int nk = K >> 6;
    wait_vm0();
    stage_rows<128>(A, lda, lds, tid);
    stage_rows<BN>(B, ldb, lds + AB, tid);
    stage_rows<128>(A + 64, lda, lds + STG, tid);
    stage_rows<BN>(B + 64, ldb, lds + STG + AB, tid);
    int cb = 0;
    for (int kt = 0; kt < nk; ++kt) {
        char* cur = lds + cb * STG;
        if (kt + 1 < nk) asm volatile("s_waitcnt vmcnt(6)" ::: "memory");
        else asm volatile("s_waitcnt vmcnt(0)" ::: "memory");
        asm volatile("s_waitcnt lgkmcnt(0)" ::: "memory");
        __builtin_amdgcn_s_barrier();
        asm volatile("" ::: "memory");
        if (kt + 2 < nk) {
            const int nb = cb == 0 ? 2 : cb - 1;
            char* nxt = lds + nb * STG;
            stage_rows<128>(A + (size_t)(kt + 2) * 64, lda, nxt, tid);
            stage_rows<BN>(B + (size_t)(kt + 2) * 64, ldb, nxt + AB, tid);
        }
        {
            bf16x8 a[2][4], b[2][NT];
#pragma unroll
            for (int ks = 0; ks < 2; ++ks) {
#pragma unroll
                for (int m = 0; m < 4; ++m) a[ks][m] = lds_frag(cur, wr * 64 + m * 16 + fr, ks * 4 + fq);
#pragma unroll
                for (int n = 0; n < NT; ++n) b[ks][n] = lds_frag(cur + AB, wc * (NT * 16) + n * 16 + fr, ks * 4 + fq);
            }
            __builtin_amdgcn_sched_barrier(0);
#pragma unroll
            for (int ks = 0; ks < 2; ++ks)
#pragma unroll
                for (int m = 0; m < 4; ++m)
#pragma unroll
                    for (int n = 0; n < NT; ++n) acc[m][n] = TR ? mfma16(b[ks][n], a[ks][m], acc[m][n]) : mfma16(a[ks][m], b[ks][n], acc[m][n]);
        }
        cb = cb == 2 ? 0 : cb + 1;
    }
    __syncthreads();
}

DEV int win_map(int c) { return c < 1792 ? c : (c < 3840 ? c + 32 : (c < 3872 ? c - 2048 : (c < 3968 ? -1 : c - 96))); }
DEV int wfi_map(int c) { const int tn = c >> 7, wc = (c >> 6) & 1, nt = (c >> 4) & 3, fr = c & 15; return (nt >> 1) * 2816 + tn * 64 + wc * 32 + (nt & 1) * 16 + fr; }

DEV void conv_tile(const float* src, size_t ld, int K, int kind, int n0, int k0, u16* dst, char* lds, int tid) {
    float* tile = (float*)lds;
    const int c = tid & 63;
    const int nn = n0 + c;
    const int sc = kind == 0 ? win_map(nn) : (kind == 3 ? wfi_map(nn) : nn);
    const int kb = tid >> 6;
    float v[32];
#pragma unroll
    for (int i = 0; i < 32; ++i) v[i] = sc >= 0 ? src[(size_t)(k0 + i * 4 + kb) * ld + sc] : 0.f;
#pragma unroll
    for (int i = 0; i < 32; ++i) tile[(i * 4 + kb) * 65 + c] = v[i];
    __syncthreads();
    const int nrow = tid >> 2, kq = tid & 3;
    unsigned w[16];
#pragma unroll
    for (int i = 0; i < 16; ++i) w[i] = pack2(tile[(kq * 32 + 2 * i) * 65 + nrow], tile[(kq * 32 + 2 * i + 1) * 65 + nrow]);
    u16* d = dst + (size_t)(n0 + nrow) * K + k0 + kq * 32;
#pragma unroll
    for (int i = 0; i < 4; ++i) *(u32x4*)(d + i * 8) = (u32x4){w[4 * i], w[4 * i + 1], w[4 * i + 2], w[4 * i + 3]};
    __syncthreads();
}

constexpr int NCONV = 880 + 192 + 128 + 704 + 352;
DEV void conv_item(const Params& p, int l, int it, char* lds, int tid) {
    char* ws = p.ws;
    if (it < 880) { conv_tile(p.w_in + (size_t)l * 1024 * NIN_SRC, NIN_SRC, 1024, 0, (it >> 3) * 64, (it & 7) * 128, (u16*)(ws + OFF_WIN), lds, tid); return; }
    it -= 880;
    if (it < 192) { const int i = it / 64, r = it % 64; conv_tile(p.w_branch + (size_t)(l * 3 + i) * 512 * 1024, 1024, 512, 1, (r >> 2) * 64, (r & 3) * 128, (u16*)(ws + OFF_WBR) + (size_t)i * 1024 * 512, lds, tid); return; }
    it -= 192;
    if (it < 128) { conv_tile(p.w_out + (size_t)l * 1024 * 1024, 1024, 1024, 2, (it >> 3) * 64, (it & 7) * 128, (u16*)(ws + OFF_WOUT), lds, tid); return; }
    it -= 128;
    if (it < 704) { conv_tile(p.w_ffn_in + (size_t)l * 1024 * 5632, 5632, 1024, 3, (it >> 3) * 64, (it & 7) * 128, (u16*)(ws + OFF_WFI), lds, tid); return; }
    it -= 704;
    { conv_tile(p.w_ffn_out + (size_t)l * 2816 * 1024, 1024, 2816, 4, (it / 22) * 64, (it % 22) * 128, (u16*)(ws + OFF_WFO), lds, tid); }
}

constexpr int NMOD = 384;
DEV void mod_item(const Params& p, int it, char* lds, int tid) {
    const int l = it / 192, cb = it % 192;
    float* sc = (float*)lds;
    float* red = (float*)(lds + 12288);
    for (int i = tid; i < 3072; i += 256) {
        const int cnd = i >> 10, k = i & 1023;
        const float v = cnd == 0 ? p.c_ctx[k] : p.c[(cnd - 1) * 1024 + k];
        sc[i] = siluf_(v);
    }
    __syncthreads();
    const int cgp = tid & 7, kg = tid >> 3;
    float acc[3][4];
#pragma unroll
    for (int a = 0; a < 3; ++a)
#pragma unroll
        for (int b = 0; b < 4; ++b) acc[a][b] = 0.f;
    const float* wbase = p.w_mod + (size_t)l * 1024 * 6144 + cb * 32 + cgp * 4;
#pragma unroll 16
    for (int kk = 0; kk < 32; ++kk) {
        const int k = kg * 32 + kk;
        const float4 w = *(const float4*)(wbase + (size_t)k * 6144);
#pragma unroll
        for (int a = 0; a < 3; ++a) { const float sv = sc[a * 1024 + k]; acc[a][0] += sv * w.x; acc[a][1] += sv * w.y; acc[a][2] += sv * w.z; acc[a][3] += sv * w.w; }
    }
#pragma unroll
    for (int a = 0; a < 3; ++a)
#pragma unroll
        for (int b = 0; b < 4; ++b) red[(kg * 3 + a) * 32 + cgp * 4 + b] = acc[a][b];
    __syncthreads();
    if (tid < 96) {
        const int a = tid >> 5, col = tid & 31;
        float sum = p.b_mod[l * 6144 + cb * 32 + col];
#pragma unroll
        for (int g = 0; g < 32; ++g) sum += red[(g * 3 + a) * 32 + col];
        ((float*)(p.ws + OFF_MOD))[(l * 3 + a) * 6144 + cb * 32 + col] = sum;
    }
    __syncthreads();
}

DEV void rope_item(const Params& p, int tid) {
    float* tab = (float*)(p.ws + OFF_ROPE);
    for (int i = tid; i < 1024; i += 256) {
        const int pos = i >> 4, f = i & 15;
        const float freq = powf(10000.0f, -(float)f / 16.0f);
        const float ang = (float)pos * freq;
        tab[i * 2] = cosf(ang);
        tab[i * 2 + 1] = sinf(ang);
    }
}

constexpr int NCACHE = 1280;
DEV void cache_item(const Params& p, int l, int it, int tid) {
    char* ws = p.ws;
    float v[4];
    size_t doff[4];
    u16* dbase[4];
#pragma unroll
    for (int u = 0; u < 4; ++u) {
        const int idx = it * 1024 + u * 256 + tid;
        const int bp = idx / 1280, r = idx % 1280;
        const int b = bp >> 9, pp = bp & 511;
        const size_t srow = (size_t)((b * 2 + l) * 512 + pp);
        if (r < 128) { const int kv = r >> 6, d = r & 63; dbase[u] = (u16*)(ws + OFF_KGL); doff[u] = (size_t)((b * 2 + kv) * 4608 + 4096 + pp) * 64 + d; v[u] = p.cache_gqa_k[srow * 128 + r]; }
        else if (r < 256) { const int r2 = r - 128, kv = r2 >> 6, d = r2 & 63; dbase[u] = (u16*)(ws + OFF_VGL); doff[u] = (size_t)((b * 2 + kv) * 64 + d) * 4608 + 4096 + pp; v[u] = p.cache_gqa_v[srow * 128 + r2]; }
        else if (r < 768) { const int r2 = r - 256, hm = r2 >> 6, d = r2 & 63; dbase[u] = (u16*)(ws + OFF_KDL); doff[u] = (size_t)((b * 8 + hm) * 4608 + 4096 + pp) * 64 + d; v[u] = p.cache_diff_k[srow * 512 + r2]; }
        else { const int r2 = r - 768, h = r2 >> 7, e = r2 & 127; dbase[u] = (u16*)(ws + OFF_VDL); doff[u] = (size_t)((b * 4 + h) * 128 + e) * 4608 + 4096 + pp; v[u] = p.cache_diff_v[srow * 512 + r2]; }
    }
#pragma unroll
    for (int u = 0; u < 4; ++u) dbase[u][doff[u]] = f2bf(v[u]);
}

template <int RW = 4>
DEV void norm_item(const Params& p, int l, int which, int it, int tid) {
    const int lane = tid & 63, wid = __builtin_amdgcn_readfirstlane(tid >> 6);
    const int tb = it * (4 * RW) + wid * RW;
    const float* g = (which == 0 ? p.norm1 : p.norm2) + l * 1024;
    const float* mod = (const float*)(p.ws + OFF_MOD) + (size_t)(l * 3 + tok_cond(tb)) * 6144 + (which == 0 ? 0 : 3072);
    float4 v[RW][4];
#pragma unroll
    for (int r = 0; r < RW; ++r) {
        const int t = tb + r;
        if (which == 0 && l == 0) {
            const float* xr = t < 4096 ? p.x_prompt + (size_t)t * 1024 : p.x_sample + (size_t)(t - 4096) * 1024;
#pragma unroll
            for (int i = 0; i < 4; ++i) v[r][i] = *(const float4*)(xr + i * 256 + lane * 4);
        } else {
            const u16* xr = (const u16*)(p.ws + OFF_XB) + (size_t)t * 1024;
#pragma unroll
            for (int i = 0; i < 4; ++i) {
                const u32x2 w = *(const u32x2*)(xr + i * 256 + lane * 4);
                v[r][i] = make_float4(__uint_as_float(w.x << 16), __uint_as_float(w.x & 0xffff0000u), __uint_as_float(w.y << 16), __uint_as_float(w.y & 0xffff0000u));
            }
        }
    }
    float4 gg[4], sh[4], scv[4];
#pragma unroll
    for (int i = 0; i < 4; ++i) {
        const int e = i * 256 + lane * 4;
        gg[i] = *(const float4*)(g + e); sh[i] = *(const float4*)(mod + e); scv[i] = *(const float4*)(mod + 1024 + e);
        gg[i].x *= 1.f + scv[i].x; gg[i].y *= 1.f + scv[i].y; gg[i].z *= 1.f + scv[i].z; gg[i].w *= 1.f + scv[i].w;
    }
#pragma unroll
    for (int r = 0; r < RW; ++r) {
        float ss = 0.f;
#pragma unroll
        for (int i = 0; i < 4; ++i) ss += v[r][i].x * v[r][i].x + v[r][i].y * v[r][i].y + v[r][i].z * v[r][i].z + v[r][i].w * v[r][i].w;
#pragma unroll
        for (int o = 1; o < 64; o <<= 1) ss += __shfl_xor(ss, o);
        const float rstd = rsqrtf(ss * (1.0f / 1024.0f) + EPSV);
        u16* hr = (u16*)(p.ws + OFF_H) + (size_t)(tb + r) * 1024;
#pragma unroll
        for (int i = 0; i < 4; ++i) {
            const int e = i * 256 + lane * 4;
            const float a = v[r][i].x * rstd * gg[i].x + sh[i].x;
            const float b = v[r][i].y * rstd * gg[i].y + sh[i].y;
            const float c = v[r][i].z * rstd * gg[i].z + sh[i].z;
            const float d = v[r][i].w * rstd * gg[i].w + sh[i].w;
            *(u32x2*)(hr + e) = (u32x2){pack2(a, b), pack2(c, d)};
        }
    }
}

DEV void acc_to_rows(const f32x4 (&acc)[4][4], char* lds, int wid, int lane_in, float (&v)[64]) {
    int lane = lane_in;
    asm volatile("" : "+v"(lane));
    float* wt = (float*)(lds + wid * 16384);
    const int fr = lane & 15, fq = lane >> 4;
    int bj[4], bn[4];
#pragma unroll
    for (int j = 0; j < 4; ++j) bj[j] = fq * 256 + (fr ^ (4 * j)) + j * 64;
#pragma unroll
    for (int n = 0; n < 4; ++n) bn[n] = 16 * (n ^ fq);
#pragma unroll
    for (int m = 0; m < 4; ++m)
#pragma unroll
        for (int n = 0; n < 4; ++n)
#pragma unroll
            for (int j = 0; j < 4; ++j) wt[bj[j] + bn[n] + m * 1024] = acc[m][n][j];
    __syncthreads();
#pragma unroll
    for (int c4 = 0; c4 < 16; ++c4) {
        const float4 x = *(const float4*)(wt + lane * 64 + ((c4 ^ (lane & 15)) << 2));
        v[c4 * 4] = x.x; v[c4 * 4 + 1] = x.y; v[c4 * 4 + 2] = x.z; v[c4 * 4 + 3] = x.w;
    }
    __syncthreads();
}

DEV void row_norm_rope(float (&v)[64], const float* gain, bool rope, int n, const float* tab, float scale) {
    float ss = 0.f;
#pragma unroll
    for (int c = 0; c < 64; ++c) ss += v[c] * v[c];
    const float r = rsqrtf(ss * (1.0f / 64.0f) + EPSV);
#pragma unroll
    for (int c = 0; c < 64; ++c) v[c] = v[c] * r * gain[c];
    if (rope) {
        const int rp = n >> 6, cp = n & 63;
#pragma unroll
        for (int i = 0; i < 16; ++i) {
            const float2 a = *(const float2*)(tab + (rp * 16 + i) * 2);
            const float2 b = *(const float2*)(tab + (cp * 16 + i) * 2);
            const float x0 = v[i], x1 = v[16 + i], x2 = v[32 + i], x3 = v[48 + i];
            v[i] = x0 * a.x - x1 * a.y; v[16 + i] = x1 * a.x + x0 * a.y;
            v[32 + i] = x2 * b.x - x3 * b.y; v[48 + i] = x3 * b.x + x2 * b.y;
        }
    }
#pragma unroll
    for (int c = 0; c < 64; ++c) v[c] *= scale;
}
DEV void row_store_bf16(const float (&v)[64], u16* dst0, size_t ld, char* wl, int lane) {
#pragma unroll
    for (int i = 0; i < 8; ++i)
        *(u32x4*)(wl + lane * 128 + ((i ^ (lane & 7)) << 4)) = (u32x4){pack2(v[i * 8], v[i * 8 + 1]), pack2(v[i * 8 + 2], v[i * 8 + 3]), pack2(v[i * 8 + 4], v[i * 8 + 5]), pack2(v[i * 8 + 6], v[i * 8 + 7])};
    __builtin_amdgcn_wave_barrier();
    const int c = lane & 7;
#pragma unroll
    for (int i = 0; i < 8; ++i) {
        const int row = i * 8 + (lane >> 3);
        const u32x4 x = *(const u32x4*)(wl + row * 128 + ((c ^ (row & 7)) << 4));
        *(u32x4*)(dst0 + (size_t)row * ld + c * 8) = x;
    }
}
DEV void row_store_f32(const float (&v)[64], float* dst) {
#pragma unroll
    for (int i = 0; i < 16; ++i) *(float4*)(dst + i * 4) = make_float4(v[i * 4], v[i * 4 + 1], v[i * 4 + 2], v[i * 4 + 3]);
}
DEV void col_store_bf16(const float (&v)[64], u16* dst, size_t ld) {
#pragma unroll
    for (int c = 0; c < 64; ++c) dst[(size_t)c * ld] = f2bf(v[c]);
}

DEV void p1_tile(const Params& p, int l, int tile, char* lds, int tid) {
    char* ws = p.ws;
    const int tm = tile % 96, tn = tile / 96;
    const int lane = tid & 63, wid = __builtin_amdgcn_readfirstlane(tid >> 6), wr = wid >> 1, wc = wid & 1;
    float v[64];
    {
        f32x4 acc[4][4];
        zero_acc<4>(acc);
        gemm_mainloop<4>(acc, (const u16*)(ws + OFF_H) + (size_t)tm * 128 * 1024, 1024, (const u16*)(ws + OFF_WIN) + (size_t)tn * 128 * 1024, 1024, 1024, lds, tid);
        acc_to_rows(acc, lds, wid, lane, v);
    }
    const int t0 = tm * 128 + wr * 64;
    const bool lat = t0 >= 4096;
    const int bs = tok_bs(t0), n0 = tok_n(t0);
    const int t = t0 + lane, n = n0 + lane;
    char* wl = lds + wid * 16384;
    const float* tab = (const float*)(ws + OFF_ROPE);
    const int S = lat ? 4608 : 256;
    const int col = tn * 128 + wc * 64;
    if (tn < 4) {
        row_norm_rope(v, p.gqa_q_norm + l * 64, lat, n, tab, QSCALE);
        row_store_bf16(v, (u16*)(ws + OFF_QG) + (size_t)t0 * 512 + col, 512, wl, lane);
    } else if (tn == 4) {
        const int kv = wc;
        row_norm_rope(v, p.gqa_k_norm + l * 64, lat, n, tab, 1.0f);
        row_store_bf16(v, kg_ptr(ws, bs, kv) + (size_t)n0 * 64, 64, wl, lane);
        if (!lat) row_store_f32(v, p.out + OUT_GK + (size_t)((bs * 2 + l) * 256 + n) * 128 + kv * 64);
    } else if (tn == 5) {
        const int kv = wc;
        col_store_bf16(v, vgt_ptr(ws, bs, kv) + n, S);
        if (!lat) row_store_f32(v, p.out + OUT_GV + (size_t)((bs * 2 + l) * 256 + n) * 128 + kv * 64);
    } else if (tn < 8) {
#pragma unroll
        for (int c = 0; c < 64; ++c) v[c] *= 0.125f;
        row_store_bf16(v, (u16*)(ws + OFF_LQ) + (size_t)t0 * 256 + (col - 768), 256, wl, lane);
    } else if (tn < 10) {
        row_store_bf16(v, (u16*)(ws + OFF_LK) + (size_t)t0 * 256 + (col - 1024), 256, wl, lane);
    } else if (tn < 14) {
        const int c2 = col - 1280, h = c2 >> 7, e0 = c2 & 127;
        const int N = lat ? 4096 : 256;
        col_store_bf16(v, lvt_ptr(ws, bs, h) + (size_t)e0 * N + n, N);
    } else if (tn < 18) {
#pragma unroll
        for (int c = 0; c < 64; ++c) v[c] = siluf_(v[c]);
        row_store_bf16(v, (u16*)(ws + OFF_LGO) + (size_t)t0 * 512 + (col - 1792), 512, wl, lane);
    } else if (tn < 22) {
        row_norm_rope(v, p.diff_q_norm + l * 64, lat, n, tab, QSCALE);
        row_store_bf16(v, (u16*)(ws + OFF_QD) + (size_t)t0 * 512 + (col - 2304), 512, wl, lane);
    } else if (tn < 26) {
        const int hm = (col - 2816) >> 6;
        row_norm_rope(v, p.diff_k_norm + l * 64, lat, n, tab, 1.0f);
        row_store_bf16(v, kd_ptr(ws, bs, hm) + (size_t)n0 * 64, 64, wl, lane);
        if (!lat) row_store_f32(v, p.out + OUT_DK + (size_t)((bs * 2 + l) * 256 + n) * 512 + hm * 64);
    } else if (tn < 30) {
        const int c2 = col - 3328, h = c2 >> 7, e0 = c2 & 127;
        col_store_bf16(v, vdt_ptr(ws, bs, h) + (size_t)e0 * S + n, S);
        if (!lat) row_store_f32(v, p.out + OUT_DV + (size_t)((bs * 2 + l) * 256 + n) * 512 + c2);
    } else {
        if (wc == 0) {
            float* lr = (float*)(ws + OFF_LR) + (size_t)t * 32;
#pragma unroll
            for (int i = 0; i < 8; ++i) *(float4*)(lr + i * 4) = make_float4(v[i * 4], v[i * 4 + 1], v[i * 4 + 2], v[i * 4 + 3]);
        }
    }
    __syncthreads();
}

template <int DV>
DEV void attn_item(const u16* Qbase, int qcol, int trow0, const u16* Kp, const u16* VTp, int S, u16* Obase, int ostride, int ocol, char* lds, int tid) {
    const int lane = tid & 63, wid = __builtin_amdgcn_readfirstlane(tid >> 6), q = lane & 31, h = lane >> 5;
    constexpr int NDT = DV / 32;
    constexpr int KB = 64 * 128, VB = DV * 128;
    char* Kr = lds;
    char* Vr = lds + 3 * KB;
    bf16x8 qf[4];
#pragma unroll
    for (int ks = 0; ks < 4; ++ks) qf[ks] = *(const bf16x8*)(Qbase + (size_t)(trow0 + wid * 32 + q) * 512 + qcol + ks * 16 + h * 8);
    f32x16 o[NDT];
#pragma unroll
    for (int d = 0; d < NDT; ++d)
#pragma unroll
        for (int r = 0; r < 16; ++r) o[d][r] = 0.f;
    float m = 0.f, l = 0.f;
    float lo_thr = -8.0f;
    const int krow = (q & 19) | ((q & 4) << 1) | ((q & 8) >> 1);
    const int nt = S >> 6;
    auto qk = [&](f32x16 (&sc)[2], const char* kb) {
#pragma unroll
        for (int mt = 0; mt < 2; ++mt) {
            bf16x8 kf[4];
#pragma unroll
            for (int ks = 0; ks < 4; ++ks) kf[ks] = lds_frag1(kb, mt * 32 + krow, ks * 2 + h);
#pragma unroll
            for (int r = 0; r < 16; ++r) sc[mt][r] = 0.f;
#pragma unroll
            for (int ks = 0; ks < 4; ++ks) sc[mt] = mfma32(kf[ks], qf[ks], sc[mt]);
        }
    };
    auto step = [&](int it, f32x16 (&s)[2], f32x16 (&sn)[2]) {
        if (it > 0) { wait_vm0(); __syncthreads(); }
        if (it + 1 < nt) stage_rows<DV, 1>(VTp + (size_t)(it + 1) * 64, (unsigned)S, Vr + ((it + 1) & 1) * VB, tid);
        if (it + 2 < nt) stage_rows<64, 1>(Kp + (size_t)(it + 2) * 64 * 64, 64, Kr + ((it + 2) % 3) * KB, tid);
        qk(sn, Kr + ((it + 1) % 3) * KB);
        float mx = fmaxf(fmaxf(s[0][0], s[0][1]), s[0][2]);
#pragma unroll
        for (int r = 3; r < 15; r += 2) mx = fmaxf(fmaxf(mx, s[0][r]), s[0][r + 1]);
        mx = fmaxf(fmaxf(mx, s[0][15]), s[1][0]);
#pragma unroll
        for (int r = 1; r < 15; r += 2) mx = fmaxf(fmaxf(mx, s[1][r]), s[1][r + 1]);
        mx = fmaxf(mx, s[1][15]);
        mx = fmaxf(mx, __shfl_xor(mx, 32));
        const float rel = mx - m;
        const bool mv = rel > 8.0f || rel < lo_thr;
        lo_thr = -3.0e38f;
        if (__any(mv)) {
            const float delta = mv ? rel : 0.f;
            m += delta;
            const float alpha = delta > 0.f ? __builtin_amdgcn_exp2f(-delta) : 1.0f;
            l *= alpha;
#pragma unroll
            for (int d = 0; d < NDT; ++d) o[d] = o[d] * alpha;
        }
        if (__any(m != 0.f)) { s[0] = s[0] - m; s[1] = s[1] - m; }
#pragma unroll
        for (int mt = 0; mt < 2; ++mt)
#pragma unroll
            for (int r = 0; r < 16; ++r) s[mt][r] = __builtin_amdgcn_exp2f(s[mt][r]);
        {
            float a0 = s[0][0] + s[1][0], a1 = s[0][1] + s[1][1], a2 = s[0][2] + s[1][2], a3 = s[0][3] + s[1][3];
#pragma unroll
            for (int r = 4; r < 16; r += 4) { a0 += s[0][r] + s[1][r]; a1 += s[0][r + 1] + s[1][r + 1]; a2 += s[0][r + 2] + s[1][r + 2]; a3 += s[0][r + 3] + s[1][r + 3]; }
            l += (a0 + a1) + (a2 + a3);
        }
        bf16x8 pf[4];
#pragma unroll
        for (int kk = 0; kk < 4; ++kk) {
            const int mt = kk >> 1, t = (kk & 1) * 8;
            u32x4 w;
            w.x = pack2(s[mt][t], s[mt][t + 1]); w.y = pack2(s[mt][t + 2], s[mt][t + 3]);
            w.z = pack2(s[mt][t + 4], s[mt][t + 5]); w.w = pack2(s[mt][t + 6], s[mt][t + 7]);
            pf[kk] = __builtin_bit_cast(bf16x8, w);
        }
        asm volatile("" ::: "memory");
        const char* vb = Vr + (it & 1) * VB;
#pragma unroll
        for (int dt = 0; dt < NDT; ++dt) {
            bf16x8 vf[4];
#pragma unroll
            for (int kk = 0; kk < 4; ++kk) vf[kk] = lds_frag1(vb, dt * 32 + q, kk * 2 + h);
#pragma unroll
            for (int kk = 0; kk < 4; ++kk) o[dt] = mfma32(vf[kk], pf[kk], o[dt]);
        }
    };
    wait_vm0();
    stage_rows<64, 1>(Kp, 64, Kr, tid);
    stage_rows<DV, 1>(VTp, (unsigned)S, Vr, tid);
    stage_rows<64, 1>(Kp + (size_t)64 * 64, 64, Kr + KB, tid);
    wait_vm0();
    __syncthreads();
    f32x16 sa[2], sb[2];
    qk(sa, Kr);
    for (int it = 0; it < nt; it += 2) {
        step(it, sa, sb);
        step(it + 1, sb, sa);
    }
    __syncthreads();
    l += __shfl_xor(l, 32);
    const float inv = 1.0f / l;
    u16* orow = Obase + (size_t)(trow0 + wid * 32 + q) * ostride + ocol + 4 * h;
#pragma unroll
    for (int d = 0; d < NDT; ++d)
#pragma unroll
        for (int g = 0; g < 4; ++g)
            *(u32x2*)(orow + 32 * d + 8 * g) = (u32x2){pack2(o[d][4 * g] * inv, o[d][4 * g + 1] * inv), pack2(o[d][4 * g + 2] * inv, o[d][4 * g + 3] * inv)};
}

DEV void gla1_item(const Params& p, int l, int it, char* lds, int tid) {
    char* ws = p.ws;
    const int gch = it >> 2, h = it & 3;
    const int t0 = gch * 64;
    const int bs = tok_bs(t0), n0 = tok_n(t0);
    const int N = bs < 16 ? 256 : 4096;
    const int lane = tid & 63, wid = __builtin_amdgcn_readfirstlane(tid >> 6), fr = lane & 15, fq = lane >> 4;
    float* lrS = (float*)lds;
    char* vT = lds + 8192;
    char* Qd = lds + 24576;
    char* Ki = lds + 32768;
    char* KteT = lds + 40960;
    char* Am = lds + 49152;
    float* tot = (float*)(lds + 57344);
    stage_rows<128>(lvt_ptr(ws, bs, h) + n0, (unsigned)N, vT, tid);
    const int d = tid & 63, qt = __builtin_amdgcn_readfirstlane(tid >> 6);
    float4 lr0, lr1;
    {
        const float4* src = (const float4*)((const float*)(ws + OFF_LR) + (size_t)t0 * 32);
        lr0 = src[tid]; lr1 = src[tid + 256];
    }
    u16 qraw[16], kraw[16];
#pragma unroll
    for (int jj = 0; jj < 16; ++jj) {
        const size_t gi = (size_t)(t0 + qt * 16 + jj) * 256 + h * 64 + d;
        qraw[jj] = ((const u16*)(ws + OFF_LQ))[gi];
        kraw[jj] = ((const u16*)(ws + OFF_LK))[gi];
    }
    float up[16], upn[16];
#pragma unroll
    for (int r = 0; r < 16; ++r) up[r] = p.gla_alpha_up[((size_t)(l * 2) * 16 + r) * 256 + h * 64 + d];
    float bias = p.gla_alpha_bias[(l * 2) * 256 + h * 64 + d], biasn;
    ((float4*)lrS)[tid] = lr0;
    ((float4*)lrS)[tid + 256] = lr1;
    wait_vm0();
    __syncthreads();
    f32x4 oacc[8];
#pragma unroll
    for (int n = 0; n < 8; ++n) oacc[n] = (f32x4){0.f, 0.f, 0.f, 0.f};
#pragma unroll 1
    for (int dir = 0; dir < 2; ++dir) {
        const int cc = (gch * 4 + h) * 2 + dir;
#pragma unroll
        for (int r = 0; r < 16; ++r) upn[r] = p.gla_alpha_up[((size_t)(l * 2 + 1) * 16 + r) * 256 + h * 64 + d];
        biasn = p.gla_alpha_bias[(l * 2 + 1) * 256 + h * 64 + d];
        float la[16];
        float run = 0.f;
#pragma unroll
        for (int jj = 0; jj < 16; ++jj) {
            const float4* lp = (const float4*)(lrS + (qt * 16 + jj) * 32 + dir * 16);
            float z = bias;
#pragma unroll
            for (int r4 = 0; r4 < 4; ++r4) { const float4 x = lp[r4]; z += x.x * up[r4 * 4] + x.y * up[r4 * 4 + 1] + x.z * up[r4 * 4 + 2] + x.w * up[r4 * 4 + 3]; }
            la[jj] = (fminf(z, 0.f) - __logf(1.0f + __expf(-fabsf(z)))) * (1.0f / 16.0f);
            run += la[jj];
            asm volatile("" ::: "memory");
        }
        tot[qt * 64 + d] = run;
        __syncthreads();
        float offs = 0.f, total = 0.f;
#pragma unroll
        for (int q2 = 0; q2 < 4; ++q2) {
            const float tv = tot[q2 * 64 + d];
            total += tv;
            if (dir == 0 ? (q2 < qt) : (q2 > qt)) offs += tv;
        }
        float cpre = dir == 0 ? offs : offs + run;
#pragma unroll
        for (int j4 = 0; j4 < 4; ++j4) {
            float kt4[4];
#pragma unroll
            for (int u = 0; u < 4; ++u) {
                const int jj = j4 * 4 + u;
                const int j = qt * 16 + jj;
                float cv;
                if (dir == 0) { cpre += la[jj]; cv = cpre; } else { cv = cpre; cpre -= la[jj]; }
                const float qv = bf2f(qraw[jj]);
                const float kv = bf2f(kraw[jj]);
                const u16 qd = f2bf(qv * __expf(cv));
                const u16 ki = f2bf(kv * __expf(-cv));
                kt4[u] = kv * __expf(total - cv);
                const int so = j * 128 + ((((d >> 3) ^ (j & 7))) << 4) + (d & 7) * 2;
                *(u16*)(Qd + so) = qd;
                *(u16*)(Ki + so) = ki;
                ((u16*)(ws + OFF_QDG))[(size_t)dir * NTOK * 256 + (size_t)(t0 + j) * 256 + h * 64 + d] = qd;
                asm volatile("" ::: "memory");
            }
            const int j0 = qt * 16 + j4 * 4;
            *(u32x2*)(KteT + d * 128 + ((((j0 >> 3) ^ (d & 7))) << 4) + (j0 & 4) * 2) = (u32x2){pack2(kt4[0], kt4[1]), pack2(kt4[2], kt4[3])};
        }
        if (qt == 0) ((float*)(ws + OFF_DECAY))[(size_t)cc * 64 + d] = __expf(total);
        __syncthreads();
        {
            f32x4 sacc[4];
#pragma unroll
            for (int n = 0; n < 4; ++n) sacc[n] = (f32x4){0.f, 0.f, 0.f, 0.f};
#pragma unroll
            for (int ks = 0; ks < 2; ++ks) {
                const bf16x8 a = lds_frag(Qd, wid * 16 + fr, ks * 4 + fq);
#pragma unroll
                for (int n = 0; n < 4; ++n) sacc[n] = mfma16(a, lds_frag(Ki, n * 16 + fr, ks * 4 + fq), sacc[n]);
            }
#pragma unroll
            for (int n = 0; n < 4; ++n)
#pragma unroll
                for (int r = 0; r < 4; ++r) {
                    const int i = wid * 16 + fq * 4 + r, j = n * 16 + fr;
                    const bool keep = dir == 0 ? (j <= i) : (j >= i);
                    *(u16*)(Am + i * 128 + ((((j >> 3) ^ (i & 7))) << 4) + (j & 7) * 2) = keep ? f2bf(sacc[n][r]) : (u16)0;
                }
            f32x4 dacc[2][4];
#pragma unroll
            for (int mt = 0; mt < 2; ++mt)
#pragma unroll
                for (int n = 0; n < 4; ++n) dacc[mt][n] = (f32x4){0.f, 0.f, 0.f, 0.f};
#pragma unroll
            for (int ks = 0; ks < 2; ++ks) {
                bf16x8 b[4];
#pragma unroll
                for (int n = 0; n < 4; ++n) b[n] = lds_frag(KteT, n * 16 + fr, ks * 4 + fq);
#pragma unroll
                for (int mt = 0; mt < 2; ++mt) {
                    const bf16x8 a = lds_frag(vT, wid * 32 + mt * 16 + fr, ks * 4 + fq);
#pragma unroll
                    for (int n = 0; n < 4; ++n) dacc[mt][n] = mfma16(a, b[n], dacc[mt][n]);
                }
            }
            u16* dst = (u16*)(ws + OFF_DST) + (size_t)cc * 8192;
#pragma unroll
            for (int mt = 0; mt < 2; ++mt)
#pragma unroll
                for (int n = 0; n < 4; ++n)
#pragma unroll
                    for (int r = 0; r < 4; ++r) dst[(wid * 32 + mt * 16 + fq * 4 + r) * 64 + n * 16 + fr] = f2bf(dacc[mt][n][r]);
        }
        __syncthreads();
#pragma unroll
        for (int ks = 0; ks < 2; ++ks) {
            const bf16x8 a = lds_frag(Am, wid * 16 + fr, ks * 4 + fq);
#pragma unroll
            for (int n = 0; n < 8; ++n) oacc[n] = mfma16(a, lds_frag(vT, n * 16 + fr, ks * 4 + fq), oacc[n]);
        }
        __syncthreads();
#pragma unroll
        for (int r = 0; r < 16; ++r) up[r] = upn[r];
        bias = biasn;
    }
    u32x2* oi = (u32x2*)(ws + OFF_OI) + ((size_t)it * 4 + wid) * 8 * 64;
#pragma unroll
    for (int n = 0; n < 8; ++n) oi[n * 64 + lane] = (u32x2){pack2(oacc[n][0], oacc[n][1]), pack2(oacc[n][2], oacc[n][3])};
}

DEV void scan_item(const Params& p, int l, int it, int tid) {
    char* ws = p.ws;
    const u16* __restrict__ dst = (const u16*)(ws + OFF_DST);
    u16* __restrict__ sp = (u16*)(ws + OFF_SPREV);
    const float* __restrict__ dec = (const float*)(ws + OFF_DECAY);
    const int d = tid & 63, wv = __builtin_amdgcn_readfirstlane(tid >> 6);
    if (it < 512) {
        const int bs = 16 + (it >> 8), rem = it & 255;
        const int h = rem >> 6, dir = (rem >> 5) & 1, eb = rem & 31;
        const int e = eb * 4 + wv;
        const int gbase = 64 + (bs - 16) * 64;
        float s = p.state_gla[((size_t)((((bs - 16) * 2 + l) * 2 + dir) * 4 + h)) * 8192 + d * 128 + e];
#pragma unroll 1
        for (int st0 = 0; st0 < 64; st0 += 32) {
            float dv[32], xv[32];
#pragma unroll
            for (int u = 0; u < 32; ++u) {
                const int c = dir == 0 ? st0 + u : 63 - (st0 + u);
                const size_t ci = (size_t)((gbase + c) * 4 + h) * 2 + dir;
                dv[u] = dec[ci * 64 + d];
                xv[u] = bf2f(dst[ci * 8192 + e * 64 + d]);
            }
#pragma unroll
            for (int u = 0; u < 32; ++u) {
                const int c = dir == 0 ? st0 + u : 63 - (st0 + u);
                const size_t ci = (size_t)((gbase + c) * 4 + h) * 2 + dir;
                sp[ci * 8192 + e * 64 + d] = f2bf(s); s = dv[u] * s + xv[u];
            }
        }
    } else {
        const int i2 = it - 512, bs = i2 >> 5, rem = i2 & 31;
        const int h = rem >> 3, dir = (rem >> 2) & 1, eq = rem & 3;
        float dv[4];
        size_t cidx[4];
#pragma unroll
        for (int st = 0; st < 4; ++st) {
            const int c = dir == 0 ? st : 3 - st;
            cidx[st] = (size_t)((bs * 4 + c) * 4 + h) * 2 + dir;
            dv[st] = dec[cidx[st] * 64 + d];
        }
        float xv[8][4];
#pragma unroll
        for (int u = 0; u < 8; ++u)
#pragma unroll
            for (int st = 0; st < 4; ++st) xv[u][st] = bf2f(dst[cidx[st] * 8192 + ((eq * 8 + u) * 4 + wv) * 64 + d]);
#pragma unroll
        for (int u = 0; u < 8; ++u) {
            const int e = (eq * 8 + u) * 4 + wv;
            float s = 0.f;
#pragma unroll
            for (int st = 0; st < 4; ++st) { sp[cidx[st] * 8192 + e * 64 + d] = f2bf(s); s = dv[st] * s + xv[u][st]; }
            p.out[OUT_ST + ((size_t)(((bs * 2 + l) * 2 + dir) * 4 + h)) * 8192 + d * 128 + e] = s;
        }
    }
}

DEV void gla3_item(const Params& p, int l, int it, int tid) {
    char* ws = p.ws;
    const int gch = it >> 2, h = it & 3;
    const int t0 = gch * 64;
    const int lane = tid & 63, wid = __builtin_amdgcn_readfirstlane(tid >> 6), fr = lane & 15, fq = lane >> 4;
    f32x4 acc[8];
    const u32x2* oi = (const u32x2*)(ws + OFF_OI) + ((size_t)it * 4 + wid) * 8 * 64;
#pragma unroll
    for (int n = 0; n < 8; ++n) {
        const u32x2 w = oi[n * 64 + lane];
        acc[n] = (f32x4){__uint_as_float(w.x << 16), __uint_as_float(w.x & 0xffff0000u), __uint_as_float(w.y << 16), __uint_as_float(w.y & 0xffff0000u)};
    }
#pragma unroll
    for (int dir = 0; dir < 2; ++dir) {
        const size_t cc = (size_t)(gch * 4 + h) * 2 + dir;
        const u16* qd = (const u16*)(ws + OFF_QDG) + (size_t)dir * NTOK * 256 + (size_t)(t0 + wid * 16 + fr) * 256 + h * 64;
        const u16* sp = (const u16*)(ws + OFF_SPREV) + cc * 8192;
#pragma unroll
        for (int ks = 0; ks < 2; ++ks) {
            const bf16x8 a = *(const bf16x8*)(qd + ks * 32 + fq * 8);
#pragma unroll
            for (int n = 0; n < 8; ++n) {
                const bf16x8 b = *(const bf16x8*)(sp + (n * 16 + fr) * 64 + ks * 32 + fq * 8);
                acc[n] = mfma16(a, b, acc[n]);
            }
        }
    }
    float gn[8];
#pragma unroll
    for (int n = 0; n < 8; ++n) gn[n] = p.gla_out_norm[l * 128 + n * 16 + fr];
#pragma unroll
    for (int r = 0; r < 4; ++r) {
        float ss = 0.f;
#pragma unroll
        for (int n = 0; n < 8; ++n) ss += acc[n][r] * acc[n][r];
        ss += __shfl_xor(ss, 1); ss += __shfl_xor(ss, 2); ss += __shfl_xor(ss, 4); ss += __shfl_xor(ss, 8);
        const float rstd = rsqrtf(ss * (1.0f / 128.0f) + EPSV);
        const size_t t = (size_t)(t0 + wid * 16 + fq * 4 + r);
        const u16* g = (const u16*)(ws + OFF_LGO) + t * 512 + h * 128;
        u16* o = (u16*)(ws + OFF_GLAOUT) + t * 512 + h * 128;
#pragma unroll
        for (int n = 0; n < 8; ++n) o[n * 16 + fr] = f2bf(acc[n][r] * rstd * gn[n] * bf2f(g[n * 16 + fr]));
    }
}

DEV float diff_lambda_val(const Params& p, int l, int lane) {
    const float* lp = p.diff_lambda + l * 256;
    float a = lp[lane] * lp[64 + lane], b = lp[128 + lane] * lp[192 + lane];
#pragma unroll
    for (int o = 1; o < 64; o <<= 1) { a += __shfl_xor(a, o); b += __shfl_xor(b, o); }
    const float lam_init = l == 0 ? 0.2f : (0.8f - 0.6f * 0.7408182206817179f);
    return __expf(a) - __expf(b) + lam_init;
}

DEV void diffc_item(const Params& p, int l, int it, int tid) {
    char* ws = p.ws;
    const int lane = tid & 63, wid = __builtin_amdgcn_readfirstlane(tid >> 6);
    const float lam = diff_lambda_val(p, l, lane);
    const float lam_init = l == 0 ? 0.2f : (0.8f - 0.6f * 0.7408182206817179f);
    const float g0 = p.diff_sub_norm[l * 128 + 2 * lane] * (1.0f - lam_init), g1 = p.diff_sub_norm[l * 128 + 2 * lane + 1] * (1.0f - lam_init);
    unsigned w1[24], w2[24];
#pragma unroll
    for (int i = 0; i < 24; ++i) {
        const int row = it * 96 + wid * 24 + i;
        const int t = row >> 2, h = row & 3;
        w1[i] = *(const unsigned*)((const u16*)(ws + OFF_DIFFO) + (size_t)t * 1024 + (h * 2) * 128 + 2 * lane);
        w2[i] = *(const unsigned*)((const u16*)(ws + OFF_DIFFO) + (size_t)t * 1024 + (h * 2 + 1) * 128 + 2 * lane);
    }
#pragma unroll
    for (int i = 0; i < 24; ++i) {
        const int row = it * 96 + wid * 24 + i;
        const int t = row >> 2, h = row & 3;
        const float a0 = __uint_as_float(w1[i] << 16) - lam * __uint_as_float(w2[i] << 16);
        const float a1 = __uint_as_float(w1[i] & 0xffff0000u) - lam * __uint_as_float(w2[i] & 0xffff0000u);
        float ss = a0 * a0 + a1 * a1;
#pragma unroll
        for (int o = 1; o < 64; o <<= 1) ss += __shfl_xor(ss, o);
        const float rstd = rsqrtf(ss * (1.0f / 128.0f) + EPSV);
        *(unsigned*)((u16*)(ws + OFF_DIFFOUT) + (size_t)t * 512 + h * 128 + 2 * lane) = pack2(a0 * rstd * g0, a1 * rstd * g1);
    }
}

DEV void p5_tile(const Params& p, int l, int tile, char* lds, int tid) {
    char* ws = p.ws;
    const int xk = tile >> 3, tm = (tile & 7) * 12 + (xk >> 4), tn = xk & 15;
    const int lane = tid & 63, wid = __builtin_amdgcn_readfirstlane(tid >> 6), wr = wid >> 1, wc = wid & 1, fr = lane & 15, fq = lane >> 4;
    f32x4 tot[4][2];
    zero_acc<2>(tot);
    for (int i = 0; i < 3; ++i) {
        f32x4 g[4][2];
        zero_acc<2>(g);
        gemm_mainloop<2, true>(g, (const u16*)(ws + OFF_H) + (size_t)tm * 128 * 1024, 1024, (const u16*)(ws + OFF_WIN) + (size_t)(3968 + i * 1024 + tn * 64) * 1024, 1024, 1024, lds, tid);
#pragma unroll
        for (int m = 0; m < 4; ++m)
#pragma unroll
            for (int n = 0; n < 2; ++n)
#pragma unroll
                for (int j = 0; j < 4; ++j) g[m][n][j] = sigmoidf_(g[m][n][j]);
        f32x4 y[4][2];
        zero_acc<2>(y);
        const u16* bo = (const u16*)(ws + (i == 0 ? OFF_QG : (i == 1 ? OFF_GLAOUT : OFF_DIFFOUT)));
        gemm_mainloop<2, true>(y, bo + (size_t)tm * 128 * 512, 512, (const u16*)(ws + OFF_WBR) + (size_t)(i * 1024 + tn * 64) * 512, 512, 512, lds, tid);
#pragma unroll
        for (int m = 0; m < 4; ++m)
#pragma unroll
            for (int n = 0; n < 2; ++n) tot[m][n] = tot[m][n] + g[m][n] * y[m][n];
    }
    u16* dst = (u16*)(ws + OFF_MIXED) + (size_t)(tm * 128 + wr * 64 + fr) * 1024 + tn * 64 + wc * 32 + fq * 4;
#pragma unroll
    for (int m = 0; m < 4; ++m)
#pragma unroll
        for (int n = 0; n < 2; ++n)
            *(u32x2*)(dst + (size_t)m * 16 * 1024 + n * 16) = (u32x2){pack2(tot[m][n][0], tot[m][n][1]), pack2(tot[m][n][2], tot[m][n][3])};
}

DEV void resid_tile(const Params& p, int l, int which, int tile, char* lds, int tid, int fuse) {
    char* ws = p.ws;
    const int xk = tile >> 3, tm = (tile & 7) * 12 + (xk >> 4), tn = xk & 15;
    const int lane = tid & 63, wid = __builtin_amdgcn_readfirstlane(tid >> 6), wr = wid >> 1, wc = wid & 1, fr = lane & 15, fq = lane >> 4;
    f32x4 acc[4][2];
    zero_acc<2>(acc);
    if (which == 0) gemm_mainloop3<2, true>(acc, (const u16*)(ws + OFF_MIXED) + (size_t)tm * 128 * 1024, 1024, (const u16*)(ws + OFF_WOUT) + (size_t)tn * 64 * 1024, 1024, 1024, lds, tid);
    else gemm_mainloop3<2, true>(acc, (const u16*)(ws + OFF_ACT) + (size_t)tm * 128 * FFH, FFH, (const u16*)(ws + OFF_WFO) + (size_t)tn * 64 * FFH, FFH, FFH, lds, tid);
    const int t0 = tm * 128 + wr * 64;
    const float* gate = (const float*)(ws + OFF_MOD) + (size_t)(l * 3 + tok_cond(t0)) * 6144 + (which == 0 ? 2048 : 5120);
    const int c0 = tn * 64 + wc * 32 + fq * 4;
    float4 gv[2];
    gv[0] = *(const float4*)(gate + c0); gv[1] = *(const float4*)(gate + c0 + 16);
#pragma unroll
    for (int m = 0; m < 4; ++m) {
        const int t = t0 + m * 16 + fr;
        const bool in_f32 = (which == 0 && l == 0);
        const bool out_f32 = (which == 1 && l == 1);
        const float* xin = t < 4096 ? p.x_prompt + (size_t)t * 1024 : p.x_sample + (size_t)(t - 4096) * 1024;
        u16* xb = (u16*)(ws + OFF_XB) + (size_t)t * 1024;
        float* xo = p.out + (size_t)t * 1024;
#pragma unroll
        for (int n = 0; n < 2; ++n) {
            float4 xi;
            if (in_f32) xi = *(const float4*)(xin + c0 + n * 16);
            else {
                const u32x2 w = *(const u32x2*)(xb + c0 + n * 16);
                xi = make_float4(__uint_as_float(w.x << 16), __uint_as_float(w.x & 0xffff0000u), __uint_as_float(w.y << 16), __uint_as_float(w.y & 0xffff0000u));
            }
            f32x4 v;
            v[0] = xi.x + gv[n].x * acc[m][n][0]; v[1] = xi.y + gv[n].y * acc[m][n][1]; v[2] = xi.z + gv[n].z * acc[m][n][2]; v[3] = xi.w + gv[n].w * acc[m][n][3];
            if (out_f32) *(f32x4*)(xo + c0 + n * 16) = v;
            else *(u32x2*)(xb + c0 + n * 16) = (u32x2){pack2(v[0], v[1]), pack2(v[2], v[3])};
        }
    }
    if (fuse >= 0) {
        volatile LAS unsigned* flag = (volatile LAS unsigned*)(lds + 73728 + 8);
        asm volatile("s_waitcnt vmcnt(0)" ::: "memory");
        __syncthreads();
        if (tid == 0) {
            const unsigned old = __hip_atomic_fetch_add((unsigned*)(ws + OFF_CNT) + fuse * 128 + tm, 1u, __ATOMIC_RELAXED, __HIP_MEMORY_SCOPE_AGENT);
            const unsigned last = (old == 15u) ? 1u : 0u;
            if (last) { __builtin_amdgcn_fence(__ATOMIC_ACQUIRE, "agent"); asm volatile("s_waitcnt vmcnt(0)" ::: "memory"); }
            flag[0] = last;
        }
        __syncthreads();
        const unsigned last = flag[0];
        if (last) {
#pragma unroll 1
            for (int i = 0; i < 4; ++i) {
                if (which == 0) norm_item<8>(p, l, 1, tm * 4 + i, tid);
                else norm_item<8>(p, l + 1, 0, tm * 4 + i, tid);
            }
        }
        __syncthreads();
    }
}

DEV void p8_tile(const Params& p, int l, int tile, char* lds, int tid, int rep = 0) {
    char* ws = p.ws;
    const int tm = tile % 96, tn = tile / 96;
    const int lane = tid & 63, wid = __builtin_amdgcn_readfirstlane(tid >> 6), wr = wid >> 1, wc = wid & 1, fr = lane & 15, fq = lane >> 4;
    f32x4 acc[4][4];
    zero_acc<4>(acc);
    gemm_mainloop<4, true>(acc, (const u16*)(ws + OFF_H) + (size_t)tm * 128 * 1024, 1024, (const u16*)(ws + OFF_WFI) + (size_t)tn * 128 * 1024, 1024, 1024, lds, tid);
    u16* dst = (u16*)(ws + OFF_ACT) + (size_t)(tm * 128 + wr * 64 + fr) * FFH + tn * 64 + wc * 32 + fq * 4;
#pragma unroll
    for (int m = 0; m < 4; ++m)
#pragma unroll
        for (int n = 0; n < 2; ++n) {
            const f32x4 a = acc[m][n], u = acc[m][n + 2];
            *(u32x2*)(dst + (size_t)m * 16 * FFH + n * 16) = (u32x2){pack2(siluf_(a[0]) * u[0], siluf_(a[1]) * u[1]), pack2(siluf_(a[2]) * u[2], siluf_(a[3]) * u[3])};
        }
}

DEV void p5_phase(const Params& p, int l, char* lds) {
    char* ws = p.ws;
    const int nitems = 96 * 16;
    int par = 0; int pre = 0;
    for (int it = blockIdx.x; it < nitems; it += gridDim.x) {
        int tid = threadIdx.x;
        asm volatile("" : "+v"(tid));
        const int lane = tid & 63, wid = __builtin_amdgcn_readfirstlane(tid >> 6), wr = wid >> 1, wc = wid & 1, fr = lane & 15, fq = lane >> 4;
        const int xk = it >> 3, tm = (it & 7) * 12 + (xk >> 4), tn = xk & 15;
        const int nit = it + gridDim.x; const bool hn = nit < nitems;
        const int nxk = nit >> 3, ntm = (nit & 7) * 12 + (nxk >> 4), ntn = nxk & 15;
        const u16* Hp = (const u16*)(ws + OFF_H);
        const u16* Wg = (const u16*)(ws + OFF_WIN) + (size_t)3968 * 1024;
        const u16* Wb = (const u16*)(ws + OFF_WBR);
        f32x4 tot[4][2];
        zero_acc<2>(tot);
#pragma unroll 1
        for (int i = 0; i < 3; ++i) {
            const u16* bo = (const u16*)(ws + (i == 0 ? OFF_QG : (i == 1 ? OFF_GLAOUT : OFF_DIFFOUT)));
            const u16* gA = Hp + (size_t)tm * 128 * 1024, *gB = Wg + (size_t)(i * 1024 + tn * 64) * 1024;
            const u16* yA = bo + (size_t)tm * 128 * 512, *yB = Wb + (size_t)(i * 1024 + tn * 64) * 512;
            f32x4 g[4][2];
            zero_acc<2>(g);
            gemm_chain2<2, true>(g, gA, 1024, gB, 1024, 1024, true, yA, 512, yB, 512, par, pre, lds, tid);
#pragma unroll
            for (int m = 0; m < 4; ++m)
#pragma unroll
                for (int n = 0; n < 2; ++n)
#pragma unroll
                    for (int j = 0; j < 4; ++j) g[m][n][j] = sigmoidf_(g[m][n][j]);
            const bool hx = i < 2 ? true : hn;
            const u16* xA = i < 2 ? gA : Hp + (size_t)ntm * 128 * 1024;
            const u16* xB = i < 2 ? Wg + (size_t)((i + 1) * 1024 + tn * 64) * 1024 : Wg + (size_t)(ntn * 64) * 1024;
            f32x4 y[4][2];
            zero_acc<2>(y);
            gemm_chain2<2, true>(y, yA, 512, yB, 512, 512, hx, xA, 1024, xB, 1024, par, pre, lds, tid);
#pragma unroll
            for (int m = 0; m < 4; ++m)
#pragma unroll
                for (int n = 0; n < 2; ++n) tot[m][n] = tot[m][n] + g[m][n] * y[m][n];
        }
        u16* dst = (u16*)(ws + OFF_MIXED) + (size_t)(tm * 128 + wr * 64 + fr) * 1024 + tn * 64 + wc * 32 + fq * 4;
#pragma unroll
        for (int m = 0; m < 4; ++m)
#pragma unroll
            for (int n = 0; n < 2; ++n)
                *(u32x2*)(dst + (size_t)m * 16 * 1024 + n * 16) = (u32x2){pack2(tot[m][n][0], tot[m][n][1]), pack2(tot[m][n][2], tot[m][n][3])};
    }
}

DEV void p8_phase(const Params& p, int l, char* lds) {
    char* ws = p.ws;
    const int nitems = 96 * 44;
    int par = 0; int pre = 0;
    for (int it = blockIdx.x; it < nitems; it += gridDim.x) {
        int tid = threadIdx.x;
        asm volatile("" : "+v"(tid));
        const int lane = tid & 63, wid = __builtin_amdgcn_readfirstlane(tid >> 6), wr = wid >> 1, wc = wid & 1, fr = lane & 15, fq = lane >> 4;
        const int tm = it % 96, tn = it / 96;
        const int nit = it + gridDim.x; const bool hn = nit < nitems;
        const int ntm = nit % 96, ntn = nit / 96;
        f32x4 acc[4][4];
        zero_acc<4>(acc);
        gemm_chain2<4, true>(acc, (const u16*)(ws + OFF_H) + (size_t)tm * 128 * 1024, 1024, (const u16*)(ws + OFF_WFI) + (size_t)tn * 128 * 1024, 1024, 1024,
                            hn, (const u16*)(ws + OFF_H) + (size_t)ntm * 128 * 1024, 1024, (const u16*)(ws + OFF_WFI) + (size_t)ntn * 128 * 1024, 1024, par, pre, lds, tid);
        u16* dst = (u16*)(ws + OFF_ACT) + (size_t)(tm * 128 + wr * 64 + fr) * FFH + tn * 64 + wc * 32 + fq * 4;
#pragma unroll
        for (int m = 0; m < 4; ++m)
#pragma unroll
            for (int n = 0; n < 2; ++n) {
                const f32x4 a = acc[m][n], u = acc[m][n + 2];
                *(u32x2*)(dst + (size_t)m * 16 * FFH + n * 16) = (u32x2){pack2(siluf_(a[0]) * u[0], siluf_(a[1]) * u[1]), pack2(siluf_(a[2]) * u[2], siluf_(a[3]) * u[3])};
            }
    }
}

DEV void p2_phase(const Params& p, int l, char* lds) {
    char* ws = p.ws;
    for (int it = blockIdx.x; it < 1024; it += gridDim.x) {
        int tid = threadIdx.x;
        asm volatile("" : "+v"(tid));
        if (it < 512) {
            const int j = it & 7, r = it >> 3, b = j >> 2, hm = (j & 3) * 2 + (r >> 5), qb = r & 31, bs = 16 + b;
            attn_item<128>((const u16*)(ws + OFF_QD), hm * 64, 4096 + b * 4096 + qb * 128, kd_ptr(ws, bs, hm), vdt_ptr(ws, bs, hm >> 1), 4608, (u16*)(ws + OFF_DIFFO), 1024, hm * 128, lds, tid);
        } else {
            const int i2 = it - 512, j = i2 & 7, r = i2 >> 3, b = j >> 2, kvh = (j >> 1) & 1, hh = kvh * 4 + (j & 1) * 2 + (r >> 5), qb = r & 31, bs = 16 + b;
            attn_item<64>((const u16*)(ws + OFF_QG), hh * 64, 4096 + b * 4096 + qb * 128, kg_ptr(ws, bs, hh >> 2), vgt_ptr(ws, bs, hh >> 2), 4608, (u16*)(ws + OFF_QG), 512, hh * 64, lds, tid);
        }
    }
    volatile LAS unsigned* flag = (volatile LAS unsigned*)(lds + 73728 + 8);
    unsigned* cnt = (unsigned*)(ws + OFF_CNT) + l * 64;
    for (;;) {
        int tid = threadIdx.x;
        asm volatile("" : "+v"(tid));
        __syncthreads();
        if (tid == 0) flag[0] = __hip_atomic_fetch_add(cnt, 1u, __ATOMIC_RELAXED, __HIP_MEMORY_SCOPE_AGENT);
        __syncthreads();
        const int j = __builtin_amdgcn_readfirstlane((int)flag[0]);
        if (j >= 1280) break;
        if (j < 768) gla1_item(p, l, j, lds, tid);
        else {
            const int i2 = j - 768, bs = i2 >> 5, ty = (i2 >> 4) & 1, hh = (i2 >> 1) & 7, qb = i2 & 1;
            if (ty == 0) attn_item<128>((const u16*)(ws + OFF_QD), hh * 64, bs * 256 + qb * 128, kd_ptr(ws, bs, hh), vdt_ptr(ws, bs, hh >> 1), 256, (u16*)(ws + OFF_DIFFO), 1024, hh * 128, lds, tid);
            else attn_item<64>((const u16*)(ws + OFF_QG), hh * 64, bs * 256 + qb * 128, kg_ptr(ws, bs, hh >> 2), vgt_ptr(ws, bs, hh >> 2), 256, (u16*)(ws + OFF_QG), 512, hh * 64, lds, tid);
        }
    }
}

#define XB_TMO      128
#define XB_XCNT(j)  (256  + 64 * (j))
#define XB_XSUB(j)  (1280 + 64 * (j))
#define XB_XGEN(j)  (2304 + 64 * (j))
#define XB_TOP      3328
#define XB_TOPGEN   3392
#define XCD_BAR_WORDS 3456
#define XB_SPIN_CAP (1u << 22)
DEV unsigned xb_ld(unsigned* p) { return __hip_atomic_load(p, __ATOMIC_RELAXED, __HIP_MEMORY_SCOPE_AGENT); }
DEV unsigned xb_add(unsigned* p, unsigned v) { return __hip_atomic_fetch_add(p, v, __ATOMIC_RELAXED, __HIP_MEMORY_SCOPE_AGENT); }
DEV unsigned xb_xcc_id() { return (unsigned)__builtin_amdgcn_s_getreg((3 << 11) | 20) & 0xFu; }
#define XB_SPIN(cond, bar) do { unsigned _sp = 0; while (cond) { __builtin_amdgcn_s_sleep(1); \
    if ((++_sp & 255u) == 0u) { if (xb_ld(&(bar)[XB_TMO])) break; if (_sp > XB_SPIN_CAP) { atomicAdd(&(bar)[XB_TMO], 1u); break; } } } } while (0)
struct XcdBarrier { unsigned* bar; unsigned x; volatile LAS unsigned* st; };
DEV XcdBarrier xcd_barrier_post(unsigned* bar, volatile LAS unsigned* st) {
    XcdBarrier b; b.bar = bar; b.x = xb_xcc_id(); b.st = st;
    if (threadIdx.x == 0) (void)xb_add(&bar[XB_XCNT(b.x)], 1u);
    return b;
}
DEV void xcd_barrier_complete(unsigned* bar, unsigned x, unsigned& nloc, unsigned& nx) {
    const unsigned G = gridDim.x * gridDim.y * gridDim.z;
    unsigned sum, cnt, mine, sp = 0u;
    for (;;) {
        sum = 0u; cnt = 0u; mine = 0u;
#pragma unroll
        for (unsigned j = 0; j < 16; ++j) { const unsigned c = xb_ld(&bar[XB_XCNT(j)]); sum += c; cnt += (c > 0u) ? 1u : 0u; mine = (j == x) ? c : mine; }
        if (sum == G) break;
        __builtin_amdgcn_s_sleep(1);
        if ((++sp & 255u) == 0u) { if (xb_ld(&bar[XB_TMO])) break; if (sp > XB_SPIN_CAP) { atomicAdd(&bar[XB_TMO], 1u); break; } }
    }
    nloc = mine > 0u ? mine : 1u; nx = cnt > 0u ? cnt : 1u;
}
DEV void xcd_barrier(const XcdBarrier& b) {
    asm volatile("s_waitcnt vmcnt(0)" ::: "memory");
    __syncthreads();
    if (threadIdx.x == 0) {
        unsigned* bar = b.bar;
        __builtin_amdgcn_s_waitcnt(0);
        unsigned nloc = b.st[0], nx = b.st[1];
        if (nloc == 0u) { xcd_barrier_complete(bar, b.x, nloc, nx); b.st[0] = nloc; b.st[1] = nx; }
        const unsigned old = xb_add(&bar[XB_XSUB(b.x)], 1u);
        const unsigned gen = old / nloc;
        if (old + 1u == (gen + 1u) * nloc) {
            __builtin_amdgcn_fence(__ATOMIC_RELEASE, "agent");
            asm volatile("s_waitcnt vmcnt(0)" ::: "memory");
            const unsigned og = xb_add(&bar[XB_TOP], 1u);
            const unsigned tg = og / nx;
            if (og + 1u == (tg + 1u) * nx) xb_add(&bar[XB_TOPGEN], 1u);
            else XB_SPIN(xb_ld(&bar[XB_TOPGEN]) == tg, bar);
            __builtin_amdgcn_fence(__ATOMIC_ACQUIRE, "agent");
            xb_add(&bar[XB_XGEN(b.x)], 1u);
            asm volatile("s_waitcnt vmcnt(0)" ::: "memory");
        } else {
            XB_SPIN(xb_ld(&bar[XB_XGEN(b.x)]) == gen, bar);
            __builtin_amdgcn_fence(__ATOMIC_ACQUIRE, "agent");
            asm volatile("s_waitcnt vmcnt(0)" ::: "memory");
        }
    }
    __syncthreads();
}

constexpr int NPHASE = 21;
__host__ __device__ inline int phase_items(int ph) {
    if (ph == 0) return NCONV + NMOD + 1 + NCACHE;
    const int l = (ph - 1) / 10, k = (ph - 1) % 10;
    switch (k) {
        case 0: return 384 + (l == 1 ? NCONV + NCACHE : 0);
        case 1: return 96 * 31;
        case 2: return 512 + 512 + 512 + 768;
        case 3: return 512 + 512;
        case 4: return 768 + 768;
        case 5: return 96 * 16;
        case 6: return 96 * 16;
        case 7: return 384;
        case 8: return 96 * 44;
        default: return 96 * 16;
    }
}

DEV void run_phase(const Params& p, int ph, char* lds, int rep = 0) {
    const int nitems = phase_items(ph);
    char* ws = p.ws;
    if (ph == 0) {
        for (int it = blockIdx.x; it < nitems; it += gridDim.x) {
            int tid = threadIdx.x;
            asm volatile("" : "+v"(tid));
            if (it < NCONV) conv_item(p, 0, it, lds, tid);
            else if (it < NCONV + NMOD) mod_item(p, it - NCONV, lds, tid);
            else if (it == NCONV + NMOD) rope_item(p, tid);
            else cache_item(p, 0, it - (NCONV + NMOD + 1), tid);
        }
        return;
    }
    const int l = (ph - 1) / 10, k = (ph - 1) % 10;
    if (k == 2) { p2_phase(p, l, lds); return; }
    if (k == 5) { p5_phase(p, l, lds); return; }
    if (k == 8) { p8_phase(p, l, lds); return; }
    for (int it = blockIdx.x; it < nitems; it += gridDim.x) {
        int tid = threadIdx.x;
        asm volatile("" : "+v"(tid));
        switch (k) {
            case 0:
                if (it < 384) norm_item<8>(p, l, 0, it, tid);
                else if (it < 384 + NCONV) conv_item(p, 1, it - 384, lds, tid);
                else cache_item(p, 1, it - 384 - NCONV, tid);
                break;
            case 1: p1_tile(p, l, it, lds, tid); break;
            case 2: {
                if (rep && ((it >= 512 && it < 1024) || (it >= 1024 && it < 1536 && ((it >> 4) & 1)))) break;
                if (it < 512) {
                    const int j = it & 7, r = it >> 3, b = j >> 2, hm = (j & 3) * 2 + (r >> 5), qb = r & 31, bs = 16 + b;
                    attn_item<128>((const u16*)(ws + OFF_QD), hm * 64, 4096 + b * 4096 + qb * 128, kd_ptr(ws, bs, hm), vdt_ptr(ws, bs, hm >> 1), 4608, (u16*)(ws + OFF_DIFFO), 1024, hm * 128, lds, tid);
                } else if (it < 1024) {
                    const int i2 = it - 512, j = i2 & 7, r = i2 >> 3, b = j >> 2, kvh = (j >> 1) & 1, hh = kvh * 4 + (j & 1) * 2 + (r >> 5), qb = r & 31, bs = 16 + b;
                    attn_item<64>((const u16*)(ws + OFF_QG), hh * 64, 4096 + b * 4096 + qb * 128, kg_ptr(ws, bs, hh >> 2), vgt_ptr(ws, bs, hh >> 2), 4608, (u16*)(ws + OFF_QG), 512, hh * 64, lds, tid);
                } else if (it < 1536) {
                    const int i2 = it - 1024, bs = i2 >> 5, ty = (i2 >> 4) & 1, hh = (i2 >> 1) & 7, qb = i2 & 1;
                    if (ty == 0) attn_item<128>((const u16*)(ws + OFF_QD), hh * 64, bs * 256 + qb * 128, kd_ptr(ws, bs, hh), vdt_ptr(ws, bs, hh >> 1), 256, (u16*)(ws + OFF_DIFFO), 1024, hh * 128, lds, tid);
                    else attn_item<64>((const u16*)(ws + OFF_QG), hh * 64, bs * 256 + qb * 128, kg_ptr(ws, bs, hh >> 2), vgt_ptr(ws, bs, hh >> 2), 256, (u16*)(ws + OFF_QG), 512, hh * 64, lds, tid);
                } else gla1_item(p, l, it - 1536, lds, tid);
                break;
            }
            case 3: scan_item(p, l, it, tid); break;
            case 4:
                if (it < 768) gla3_item(p, l, it, tid);
                else { const int j = it - 768, di = j < 256 ? j : (j >= 512 ? j - 256 : -1); if (di >= 0) diffc_item(p, l, di, tid); }
                break;
            case 5: p5_tile(p, l, it, lds, tid); break;
            case 6: resid_tile(p, l, 0, it, lds, tid, -1); break;
            case 7: norm_item<8>(p, l, 1, it, tid); break;
            case 8: p8_tile(p, l, it, lds, tid); break;
            default: resid_tile(p, l, 1, it, lds, tid, -1); break;
        }
    }
}

__global__ void __launch_bounds__(256, 2) fwd_kernel(Params p) {
    __shared__ __attribute__((aligned(16))) char lds[73728 + 16];
#ifdef ONE_LAUNCH
    volatile LAS unsigned* st = (volatile LAS unsigned*)(lds + 73728);
    if (threadIdx.x == 0) { st[0] = 0u; st[1] = 0u; }
    __syncthreads();
    XcdBarrier xb = xcd_barrier_post((unsigned*)(p.ws + OFF_BAR), st);
    if (p.pad0 == 0x7fffffff) cg::this_grid().sync();
#endif
    for (int ph = p.phase_lo; ph <= p.phase_hi; ++ph) {
        if (phase_items(ph) == 0) continue;
#ifdef PROBE_REP
        if (ph > 0 && ((PROBE_REP >> ((ph - 1) % 10)) & 1)) { run_phase(p, ph, lds, 1); xcd_barrier(xb); }
#endif
        run_phase(p, ph, lds);
#ifdef ONE_LAUNCH
        if (ph < p.phase_hi) xcd_barrier(xb);
#endif
    }
}

extern "C" void kernel_launch(void* const* d_in, const int* in_sizes, int n_in, void* d_out, int out_size, void* d_ws, size_t ws_size, hipStream_t stream) {
    Params p{};
    const float** f = (const float**)&p;
    for (int i = 0; i < 27; ++i) f[i] = (const float*)d_in[i];
    p.out = (float*)d_out;
    p.ws = (char*)d_ws;
    if (ws_size < WS_END) { fprintf(stderr, "workspace too small: %zu < %zu\n", ws_size, (size_t)WS_END); return; }
#ifndef ONE_LAUNCH
    for (int ph = 0; ph < NPHASE; ++ph) {
        Params q = p;
        q.phase_lo = ph; q.phase_hi = ph;
        int g = phase_items(ph);
        if (g > 2048) g = 2048;
        hipLaunchKernelGGL(fwd_kernel, dim3(g), dim3(256), 0, stream, q);
    }
#else
    static int grid_blocks = 0;
    if (!grid_blocks) {
        int dev = 0, cus = 0, per_cu = 0;
        hipGetDevice(&dev);
        hipDeviceGetAttribute(&cus, hipDeviceAttributeMultiprocessorCount, dev);
        hipOccupancyMaxActiveBlocksPerMultiprocessor(&per_cu, fwd_kernel, 256, 0);
        if (per_cu > 2) per_cu = 2;
        grid_blocks = cus * per_cu;
    }
    p.phase_lo = 0; p.phase_hi = NPHASE - 1;
    hipMemsetAsync((char*)d_ws + OFF_BAR, 0, (size_t)(OFF_CNT - OFF_BAR) + (size_t)3 * 128 * 4, stream);
    void* args[] = {&p};
    hipError_t e = hipLaunchCooperativeKernel((void*)fwd_kernel, dim3(grid_blocks), dim3(256), args, 0, stream);
    if (e != hipSuccess) fprintf(stderr, "cooperative launch failed: %s (grid %d)\n", hipGetErrorString(e), grid_blocks);
#endif
}
```

```cpp
#define ONE_LAUNCH 1
#include <hip/hip_runtime.h>
#include <hip/hip_cooperative_groups.h>
#include <cstdio>
#include <cstdint>
namespace cg = cooperative_groups;

#define DEV __device__ __forceinline__
typedef unsigned short u16;
typedef short bf16x8 __attribute__((ext_vector_type(8)));
typedef float f32x4 __attribute__((ext_vector_type(4)));
typedef unsigned u32x4 __attribute__((ext_vector_type(4)));
typedef unsigned u32x2 __attribute__((ext_vector_type(2)));
#define LAS __attribute__((address_space(3)))

constexpr int NTOK = 12288;
constexpr int DM = 1024;
constexpr int NIN_SRC = 6944;
constexpr int NWIN = 7040;
constexpr int FFH = 2816;
constexpr float EPSV = 1e-6f;
constexpr float QSCALE = 0.125f * 1.4426950408889634f;

constexpr size_t al256(size_t x) { return (x + 255) & ~(size_t)255; }
constexpr size_t OFF_WIN = 0;
constexpr size_t OFF_WBR = OFF_WIN + al256((size_t)NWIN * 1024 * 2);
constexpr size_t OFF_WOUT = OFF_WBR + al256((size_t)3 * 1024 * 512 * 2);
constexpr size_t OFF_WFI = OFF_WOUT + al256((size_t)1024 * 1024 * 2);
constexpr size_t OFF_WFO = OFF_WFI + al256((size_t)5632 * 1024 * 2);
constexpr size_t OFF_MOD = OFF_WFO + al256((size_t)1024 * 2816 * 2);
constexpr size_t OFF_ROPE = OFF_MOD + al256((size_t)2 * 3 * 6144 * 4);
constexpr size_t OFF_H = OFF_ROPE + al256((size_t)64 * 16 * 2 * 4);
constexpr size_t OFF_QG = OFF_H + al256((size_t)NTOK * 1024 * 2);
constexpr size_t OFF_QD = OFF_QG + al256((size_t)NTOK * 512 * 2);
constexpr size_t OFF_KGC = OFF_QD + al256((size_t)NTOK * 512 * 2);
constexpr size_t OFF_VGC = OFF_KGC + al256((size_t)16 * 2 * 256 * 64 * 2);
constexpr size_t OFF_KDC = OFF_VGC + al256((size_t)16 * 2 * 256 * 64 * 2);
constexpr size_t OFF_VDC = OFF_KDC + al256((size_t)16 * 8 * 256 * 64 * 2);
constexpr size_t OFF_KGL = OFF_VDC + al256((size_t)16 * 4 * 128 * 256 * 2);
constexpr size_t OFF_VGL = OFF_KGL + al256((size_t)2 * 2 * 4608 * 64 * 2);
constexpr size_t OFF_KDL = OFF_VGL + al256((size_t)2 * 2 * 4608 * 64 * 2);
constexpr size_t OFF_VDL = OFF_KDL + al256((size_t)2 * 8 * 4608 * 64 * 2);
constexpr size_t OFF_LQ = OFF_VDL + al256((size_t)2 * 4 * 128 * 4608 * 2);
constexpr size_t OFF_LK = OFF_LQ + al256((size_t)NTOK * 256 * 2);
constexpr size_t OFF_LVT = OFF_LK + al256((size_t)NTOK * 256 * 2);
constexpr size_t OFF_LGO = OFF_LVT + al256((size_t)NTOK * 512 * 2);
constexpr size_t OFF_LR = OFF_LGO + al256((size_t)NTOK * 512 * 2);
constexpr size_t OFF_DIFFO = OFF_LR + al256((size_t)NTOK * 32 * 4);
constexpr size_t OFF_QDG = OFF_DIFFO + al256((size_t)NTOK * 1024 * 2);
constexpr size_t OFF_OI = OFF_QDG + al256((size_t)2 * NTOK * 256 * 2);
constexpr size_t OFF_DST = OFF_OI + al256((size_t)768 * 4 * 8 * 64 * 8);
constexpr size_t OFF_DECAY = OFF_DST + al256((size_t)1536 * 8192 * 2);
constexpr size_t OFF_BAR = OFF_DECAY + al256((size_t)1536 * 64 * 4);
constexpr size_t OFF_CNT = OFF_BAR + al256((size_t)3456 * 4);
constexpr size_t OFF_XB = OFF_CNT + al256((size_t)3 * 128 * 4);
constexpr size_t WS_END = OFF_XB + al256((size_t)NTOK * 1024 * 2);
constexpr size_t OFF_SPREV = OFF_KGC;
constexpr size_t OFF_MIXED = OFF_KGC;
constexpr size_t OFF_GLAOUT = OFF_LQ;
constexpr size_t OFF_DIFFOUT = OFF_LVT;
constexpr size_t OFF_ACT = OFF_DIFFO;
static_assert(OFF_LQ - OFF_KGC >= (size_t)NTOK * 1024 * 2, "alias");
static_assert(OFF_DECAY - OFF_DIFFO >= (size_t)NTOK * 2816 * 2, "alias");
static_assert(WS_END <= (size_t)256 * 1024 * 1024, "ws");

constexpr size_t OUT_GK = 12582912, OUT_GV = 13631488, OUT_ST = 14680064, OUT_DK = 16777216, OUT_DV = 20971520;

struct Params {
    const float *x_prompt, *x_sample, *c, *cache_gqa_k, *cache_gqa_v, *state_gla, *cache_diff_k, *cache_diff_v, *c_ctx,
        *w_mod, *b_mod, *norm1, *norm2, *w_in, *gqa_q_norm, *gqa_k_norm, *gla_alpha_up, *gla_alpha_bias, *gla_out_norm,
        *diff_q_norm, *diff_k_norm, *diff_lambda, *diff_sub_norm, *w_branch, *w_out, *w_ffn_in, *w_ffn_out;
    float* out;
    char* ws;
    int phase_lo, phase_hi, pad0, pad1;
};

typedef __bf16 bf16x2_t __attribute__((ext_vector_type(2)));
typedef float f32x2_t __attribute__((ext_vector_type(2)));
DEV u16 f2bf(float f) { const __bf16 b = (__bf16)f; return __builtin_bit_cast(u16, b); }
DEV float bf2f(u16 h) { return __uint_as_float(((unsigned)h) << 16); }
DEV unsigned pack2(float lo, float hi) { const f32x2_t v = {lo, hi}; const bf16x2_t b = __builtin_convertvector(v, bf16x2_t); return __builtin_bit_cast(unsigned, b); }
DEV float sigmoidf_(float x) { return 1.0f / (1.0f + __expf(-x)); }
DEV float siluf_(float x) { return x / (1.0f + __expf(-x)); }
DEV int tok_cond(int t) { return t < 4096 ? 0 : 1 + ((t - 4096) >> 12); }
DEV int tok_bs(int t) { return t < 4096 ? (t >> 8) : 16 + ((t - 4096) >> 12); }
DEV int tok_n(int t) { return t < 4096 ? (t & 255) : ((t - 4096) & 4095); }
DEV f32x4 mfma16(bf16x8 a, bf16x8 b, f32x4 c) { return __builtin_amdgcn_mfma_f32_16x16x32_bf16(a, b, c, 0, 0, 0); }

DEV u16* kg_ptr(char* ws, int bs, int kv) { return bs < 16 ? (u16*)(ws + OFF_KGC) + (size_t)((bs * 2 + kv) * 256) * 64 : (u16*)(ws + OFF_KGL) + (size_t)(((bs - 16) * 2 + kv) * 4608) * 64; }
DEV u16* vgt_ptr(char* ws, int bs, int kv) { return bs < 16 ? (u16*)(ws + OFF_VGC) + (size_t)((bs * 2 + kv) * 64) * 256 : (u16*)(ws + OFF_VGL) + (size_t)(((bs - 16) * 2 + kv) * 64) * 4608; }
DEV u16* kd_ptr(char* ws, int bs, int hm) { return bs < 16 ? (u16*)(ws + OFF_KDC) + (size_t)((bs * 8 + hm) * 256) * 64 : (u16*)(ws + OFF_KDL) + (size_t)(((bs - 16) * 8 + hm) * 4608) * 64; }
DEV u16* vdt_ptr(char* ws, int bs, int h) { return bs < 16 ? (u16*)(ws + OFF_VDC) + (size_t)((bs * 4 + h) * 128) * 256 : (u16*)(ws + OFF_VDL) + (size_t)(((bs - 16) * 4 + h) * 128) * 4608; }
DEV u16* lvt_ptr(char* ws, int bs, int h) { return bs < 16 ? (u16*)(ws + OFF_LVT) + (size_t)((bs * 4 + h) * 128) * 256 : (u16*)(ws + OFF_LVT) + (size_t)2097152 + (size_t)(((bs - 16) * 4 + h) * 128) * 4096; }

template <int ROWS, int SW = 0>
DEV void stage_rows(const u16* g, unsigned ld, char* lds, int tid) {
    const int wbase = __builtin_amdgcn_readfirstlane(tid >> 6) * 64;
    const char* gb = (const char*)g;
#pragma unroll
    for (int i = 0; i < ROWS / 32; ++i) {
        const int idx = tid + i * 256;
        const int r = idx >> 3, s = idx & 7;
        const int c = s ^ (SW == 0 ? (r & 7) : ((r >> 1) & 7));
        const unsigned off = ((unsigned)r * ld + (unsigned)c * 8u) * 2u;
        __builtin_amdgcn_global_load_lds((const void*)(gb + off), (LAS void*)(lds + (wbase + i * 256) * 16), 16, 0, 0);
    }
}
DEV bf16x8 lds_frag(const char* tile, int row, int chunk) { return *(const bf16x8*)(tile + row * 128 + ((chunk ^ (row & 7)) << 4)); }
DEV bf16x8 lds_frag1(const char* tile, int row, int chunk) { return *(const bf16x8*)(tile + row * 128 + ((chunk ^ ((row >> 1) & 7)) << 4)); }
typedef float f32x16 __attribute__((ext_vector_type(16)));
DEV f32x16 mfma32(bf16x8 a, bf16x8 b, f32x16 c) { return __builtin_amdgcn_mfma_f32_32x32x16_bf16(a, b, c, 0, 0, 0); }
DEV void wait_vm0() { asm volatile("s_waitcnt vmcnt(0)" ::: "memory"); }

template <int NT, bool TR = false>
DEV void gemm_mainloop(f32x4 (&acc)[4][NT], const u16* A, unsigned lda, const u16* B, unsigned ldb, int K, char* lds, int tid) {
    constexpr int BN = NT * 32;
    constexpr int AB = 128 * 128, BB = BN * 128, STG = AB + BB;
    const int lane = tid & 63, wid = __builtin_amdgcn_readfirstlane(tid >> 6), wr = wid >> 1, wc = wid & 1, fr = lane & 15, fq = lane >> 4;
    const int nk = K >> 6;
    stage_rows<128>(A, lda, lds, tid);
    stage_rows<BN>(B, ldb, lds + AB, tid);
    for (int kt = 0; kt < nk; ++kt) {
        char* cur = lds + (kt & 1) * STG;
        wait_vm0();
        __syncthreads();
        if (kt + 1 < nk) {
            char* nxt = lds + ((kt + 1) & 1) * STG;
            stage_rows<128>(A + (size_t)(kt + 1) * 64, lda, nxt, tid);
            stage_rows<BN>(B + (size_t)(kt + 1) * 64, ldb, nxt + AB, tid);
        }
        {
            bf16x8 a[2][4], b[2][NT];
#pragma unroll
            for (int ks = 0; ks < 2; ++ks) {
#pragma unroll
                for (int m = 0; m < 4; ++m) a[ks][m] = lds_frag(cur, wr * 64 + m * 16 + fr, ks * 4 + fq);
#pragma unroll
                for (int n = 0; n < NT; ++n) b[ks][n] = lds_frag(cur + AB, wc * (NT * 16) + n * 16 + fr, ks * 4 + fq);
            }
            __builtin_amdgcn_sched_barrier(0);
#pragma unroll
            for (int ks = 0; ks < 2; ++ks)
#pragma unroll
                for (int m = 0; m < 4; ++m)
#pragma unroll
                    for (int n = 0; n < NT; ++n) acc[m][n] = TR ? mfma16(b[ks][n], a[ks][m], acc[m][n]) : mfma16(a[ks][m], b[ks][n], acc[m][n]);
        }
    }
    __syncthreads();
}

template <int NT>
DEV void zero_acc(f32x4 (&acc)[4][NT]) {
#pragma unroll
    for (int m = 0; m < 4; ++m)
#pragma unroll
        for (int n = 0; n < NT; ++n) acc[m][n] = (f32x4){0.f, 0.f, 0.f, 0.f};
}

template <int NT, bool TR>
DEV void gemm_chain(f32x4 (&acc)[4][NT], const u16* A, unsigned lda, const u16* B, unsigned ldb, int K,
                    bool has_next, const u16* nA, unsigned nlda, const u16* nB, unsigned nldb, int& par, bool& pre, char* lds, int tid) {
    constexpr int BN = NT * 32;
    constexpr int AB = 128 * 128, BB = BN * 128, STG = AB + BB;
    const int lane = tid & 63, wid = __builtin_amdgcn_readfirstlane(tid >> 6), wr = wid >> 1, wc = wid & 1, fr = lane & 15, fq = lane >> 4;
    const int nk = K >> 6;
    if (!pre) {
        stage_rows<128>(A, lda, lds + par * STG, tid);
        stage_rows<BN>(B, ldb, lds + par * STG + AB, tid);
    }
    for (int kt = 0; kt < nk; ++kt) {
        char* cur = lds + ((par + kt) & 1) * STG;
        char* nxt = lds + ((par + kt + 1) & 1) * STG;
        wait_vm0();
        __syncthreads();
        if (kt + 1 < nk) {
            stage_rows<128>(A + (size_t)(kt + 1) * 64, lda, nxt, tid);
            stage_rows<BN>(B + (size_t)(kt + 1) * 64, ldb, nxt + AB, tid);
        } else if (has_next) {
            stage_rows<128>(nA, nlda, nxt, tid);
            stage_rows<BN>(nB, nldb, nxt + AB, tid);
        }
        {
            bf16x8 a[2][4], b[2][NT];
#pragma unroll
            for (int ks = 0; ks < 2; ++ks) {
#pragma unroll
                for (int m = 0; m < 4; ++m) a[ks][m] = lds_frag(cur, wr * 64 + m * 16 + fr, ks * 4 + fq);
#pragma unroll
                for (int n = 0; n < NT; ++n) b[ks][n] = lds_frag(cur + AB, wc * (NT * 16) + n * 16 + fr, ks * 4 + fq);
            }
            __builtin_amdgcn_sched_barrier(0);
#pragma unroll
            for (int ks = 0; ks < 2; ++ks)
#pragma unroll
                for (int m = 0; m < 4; ++m)
#pragma unroll
                    for (int n = 0; n < NT; ++n) acc[m][n] = TR ? mfma16(b[ks][n], a[ks][m], acc[m][n]) : mfma16(a[ks][m], b[ks][n], acc[m][n]);
        }
    }
    par = (par + nk) & 1;
    pre = has_next;
    if (!has_next) __syncthreads();
}

template <int NT, bool TR>
DEV void gemm_chain2(f32x4 (&acc)[4][NT], const u16* A, unsigned lda, const u16* B, unsigned ldb, int K,
                     bool has_next, const u16* nA, unsigned nlda, const u16* nB, unsigned nldb, int& par, int& pre, char* lds, int tid) {
    constexpr int BN = NT * 32;
    constexpr int AB = 128 * 128, BB = BN * 128, STG = AB + BB;
    static_assert(NT == 2 || NT == 4, "vmcnt literals");
    const int lane = tid & 63, wid = __builtin_amdgcn_readfirstlane(tid >> 6), wr = wid >> 1, wc = wid & 1, fr = lane & 15, fq = lane >> 4;
    const int nk = K >> 6;
    if (pre < 1) { stage_rows<128>(A, lda, lds + par * STG, tid); stage_rows<BN>(B, ldb, lds + par * STG + AB, tid); }
    if (pre < 2) { stage_rows<128>(A + 64, lda, lds + (par ^ 1) * STG, tid); stage_rows<BN>(B + 64, ldb, lds + (par ^ 1) * STG + AB, tid); }
    for (int kt = 0; kt < nk; ++kt) {
        char* cur = lds + ((par + kt) & 1) * STG;
        const bool younger = (kt + 1 < nk) || has_next;
        if (kt == 0 || !younger) asm volatile("s_waitcnt vmcnt(0)" ::: "memory");
        else if (NT == 4) asm volatile("s_waitcnt vmcnt(8)" ::: "memory");
        else asm volatile("s_waitcnt vmcnt(6)" ::: "memory");
        __builtin_amdgcn_s_barrier();
        asm volatile("" ::: "memory");
        bf16x8 a[2][4], b[2][NT];
#pragma unroll
        for (int ks = 0; ks < 2; ++ks) {
#pragma unroll
            for (int m = 0; m < 4; ++m) a[ks][m] = lds_frag(cur, wr * 64 + m * 16 + fr, ks * 4 + fq);
#pragma unroll
            for (int n = 0; n < NT; ++n) b[ks][n] = lds_frag(cur + AB, wc * (NT * 16) + n * 16 + fr, ks * 4 + fq);
        }
        asm volatile("s_waitcnt lgkmcnt(0)" ::: "memory");
        __builtin_amdgcn_s_barrier();
        asm volatile("" ::: "memory");
        if (kt + 2 < nk) {
            stage_rows<128>(A + (size_t)(kt + 2) * 64, lda, cur, tid);
            stage_rows<BN>(B + (size_t)(kt + 2) * 64, ldb, cur + AB, tid);
        } else if (has_next) {
            const int j = kt + 2 - nk;
            stage_rows<128>(nA + (size_t)j * 64, nlda, cur, tid);
            stage_rows<BN>(nB + (size_t)j * 64, nldb, cur + AB, tid);
        }
        __builtin_amdgcn_sched_barrier(0);
#pragma unroll
        for (int ks = 0; ks < 2; ++ks)
#pragma unroll
            for (int m = 0; m < 4; ++m)
#pragma unroll
                for (int n = 0; n < NT; ++n) acc[m][n] = TR ? mfma16(b[ks][n], a[ks][m], acc[m][n]) : mfma16(a[ks][m], b[ks][n], acc[m][n]);
    }
    par = (par + nk) & 1;
    pre = has_next ? 2 : 0;
    if (!has_next) __syncthreads();
}

template <int NT, bool TR = false>
DEV void gemm_mainloop3(f32x4 (&acc)[4][NT], const u16* A, unsigned lda, const u16* B, unsigned ldb, int K, char* lds, int tid) {
    constexpr int BN = NT * 32;
    constexpr int AB = 128 * 128, BB = BN * 128, STG = AB + BB;
    static_assert(NT == 2, "vmcnt literal below assumes 6 DMA pieces per thread per tile");
    const int lane = tid & 63, wid = __builtin_amdgcn_readfirstlane(tid >> 6), wr = wid >> 1, wc = wid & 1, fr = lane & 15, fq = lane >> 4;
    const int nk = K >> 6;
    wait_vm0();
    stage_rows<128>(A, lda, lds, tid);
    stage_rows<BN>(B, ldb, lds + AB, tid);
    stage_rows<128>(A + 64, lda, lds + STG, tid);
    stage_rows<BN>(B + 64, ldb, lds + STG + AB, tid);
    int cb = 0;
    for (int kt = 0; kt < nk; ++kt) {
        char* cur = lds + cb * STG;
        if (kt + 1 < nk) asm volatile("s_waitcnt vmcnt(6)" ::: "memory");
        else asm volatile("s_waitcnt vmcnt(0)" ::: "memory");
        asm volatile("s_waitcnt lgkmcnt(0)" ::: "memory");
        __builtin_amdgcn_s_barrier();
        asm volatile("" ::: "memory");
        if (kt + 2 < nk) {
            const int nb = cb == 0 ? 2 : cb - 1;
            char* nxt = lds + nb * STG;
            stage_rows<128>(A + (size_t)(kt + 2) * 64, lda, nxt, tid);
            stage_rows<BN>(B + (size_t)(kt + 2) * 64, ldb, nxt + AB, tid);
        }
        {
            bf16x8 a[2][4], b[2][NT];
#pragma unroll
            for (int ks = 0; ks < 2; ++ks) {
#pragma unroll
                for (int m = 0; m < 4; ++m) a[ks][m] = lds_frag(cur, wr * 64 + m * 16 + fr, ks * 4 + fq);
#pragma unroll
                for (int n = 0; n < NT; ++n) b[ks][n] = lds_frag(cur + AB, wc * (NT * 16) + n * 16 + fr, ks * 4 + fq);
            }
            __builtin_amdgcn_sched_barrier(0);
#pragma unroll
            for (int ks = 0; ks < 2; ++ks)
#pragma unroll
                for (int m = 0; m < 4; ++m)
#pragma unroll
                    for (int n = 0; n < NT; ++n) acc[m][n] = TR ? mfma16(b[ks][n], a[ks][m], acc[m][n]) : mfma16(a[ks][m], b[ks][n], acc[m][n]);
        }
        cb = cb == 2 ? 0 : cb + 1;
    }
    __syncthreads();
}

DEV int win_map(int c) { return c < 1792 ? c : (c < 3840 ? c + 32 : (c < 3872 ? c - 2048 : (c < 3968 ? -1 : c - 96))); }
DEV int wfi_map(int c) { const int tn = c >> 7, wc = (c >> 6) & 1, nt = (c >> 4) & 3, fr = c & 15; return (nt >> 1) * 2816 + tn * 64 + wc * 32 + (nt & 1) * 16 + fr; }

DEV void conv_tile(const float* src, size_t ld, int K, int kind, int n0, int k0, u16* dst, char* lds, int tid) {
    float* tile = (float*)lds;
    const int c = tid & 63;
    const int nn = n0 + c;
    const int sc = kind == 0 ? win_map(nn) : (kind == 3 ? wfi_map(nn) : nn);
    const int kb = tid >> 6;
    float v[32];
#pragma unroll
    for (int i = 0; i < 32; ++i) v[i] = sc >= 0 ? src[(size_t)(k0 + i * 4 + kb) * ld + sc] : 0.f;
#pragma unroll
    for (int i = 0; i < 32; ++i) tile[(i * 4 + kb) * 65 + c] = v[i];
    __syncthreads();
    const int nrow = tid >> 2, kq = tid & 3;
    unsigned w[16];
#pragma unroll
    for (int i = 0; i < 16; ++i) w[i] = pack2(tile[(kq * 32 + 2 * i) * 65 + nrow], tile[(kq * 32 + 2 * i + 1) * 65 + nrow]);
    u16* d = dst + (size_t)(n0 + nrow) * K + k0 + kq * 32;
#pragma unroll
    for (int i = 0; i < 4; ++i) *(u32x4*)(d + i * 8) = (u32x4){w[4 * i], w[4 * i + 1], w[4 * i + 2], w[4 * i + 3]};
    __syncthreads();
}

constexpr int NCONV = 880 + 192 + 128 + 704 + 352;
constexpr int NCONV_EARLY = 880 + 192 + 128;
DEV void conv_item(const Params& p, int l, int it, char* lds, int tid) {
    char* ws = p.ws;
    if (it < 880) { conv_tile(p.w_in + (size_t)l * 1024 * NIN_SRC, NIN_SRC, 1024, 0, (it >> 3) * 64, (it & 7) * 128, (u16*)(ws + OFF_WIN), lds, tid); return; }
    it -= 880;
    if (it < 192) { const int i = it / 64, r = it % 64; conv_tile(p.w_branch + (size_t)(l * 3 + i) * 512 * 1024, 1024, 512, 1, (r >> 2) * 64, (r & 3) * 128, (u16*)(ws + OFF_WBR) + (size_t)i * 1024 * 512, lds, tid); return; }
    it -= 192;
    if (it < 128) { conv_tile(p.w_out + (size_t)l * 1024 * 1024, 1024, 1024, 2, (it >> 3) * 64, (it & 7) * 128, (u16*)(ws + OFF_WOUT), lds, tid); return; }
    it -= 128;
    if (it < 704) { conv_tile(p.w_ffn_in + (size_t)l * 1024 * 5632, 5632, 1024, 3, (it >> 3) * 64, (it & 7) * 128, (u16*)(ws + OFF_WFI), lds, tid); return; }
    it -= 704;
    { conv_tile(p.w_ffn_out + (size_t)l * 2816 * 1024, 1024, 2816, 4, (it / 22) * 64, (it % 22) * 128, (u16*)(ws + OFF_WFO), lds, tid); }
}

constexpr int NMOD = 384;
DEV void mod_item(const Params& p, int it, char* lds, int tid) {
    const int l = it / 192, cb = it % 192;
    float* sc = (float*)lds;
    float* red = (float*)(lds + 12288);
    for (int i = tid; i < 3072; i += 256) {
        const int cnd = i >> 10, k = i & 1023;
        const float v = cnd == 0 ? p.c_ctx[k] : p.c[(cnd - 1) * 1024 + k];
        sc[i] = siluf_(v);
    }
    __syncthreads();
    const int cgp = tid & 7, kg = tid >> 3;
    float acc[3][4];
#pragma unroll
    for (int a = 0; a < 3; ++a)
#pragma unroll
        for (int b = 0; b < 4; ++b) acc[a][b] = 0.f;
    const float* wbase = p.w_mod + (size_t)l * 1024 * 6144 + cb * 32 + cgp * 4;
#pragma unroll 16
    for (int kk = 0; kk < 32; ++kk) {
        const int k = kg * 32 + kk;
        const float4 w = *(const float4*)(wbase + (size_t)k * 6144);
#pragma unroll
        for (int a = 0; a < 3; ++a) { const float sv = sc[a * 1024 + k]; acc[a][0] += sv * w.x; acc[a][1] += sv * w.y; acc[a][2] += sv * w.z; acc[a][3] += sv * w.w; }
    }
#pragma unroll
    for (int a = 0; a < 3; ++a)
#pragma unroll
        for (int b = 0; b < 4; ++b) red[(kg * 3 + a) * 32 + cgp * 4 + b] = acc[a][b];
    __syncthreads();
    if (tid < 96) {
        const int a = tid >> 5, col = tid & 31;
        float sum = p.b_mod[l * 6144 + cb * 32 + col];
#pragma unroll
        for (int g = 0; g < 32; ++g) sum += red[(g * 3 + a) * 32 + col];
        ((float*)(p.ws + OFF_MOD))[(l * 3 + a) * 6144 + cb * 32 + col] = sum;
    }
    __syncthreads();
}

DEV void rope_item(const Params& p, int tid) {
    float* tab = (float*)(p.ws + OFF_ROPE);
    for (int i = tid; i < 1024; i += 256) {
        const int pos = i >> 4, f = i & 15;
        const float freq = powf(10000.0f, -(float)f / 16.0f);
        const float ang = (float)pos * freq;
        tab[i * 2] = cosf(ang);
        tab[i * 2 + 1] = sinf(ang);
    }
}

constexpr int NCACHE = 1280;
DEV void cache_item(const Params& p, int l, int it, int tid) {
    char* ws = p.ws;
    float v[4];
    size_t doff[4];
    u16* dbase[4];
#pragma unroll
    for (int u = 0; u < 4; ++u) {
        const int idx = it * 1024 + u * 256 + tid;
        const int bp = idx / 1280, r = idx % 1280;
        const int b = bp >> 9, pp = bp & 511;
        const size_t srow = (size_t)((b * 2 + l) * 512 + pp);
        if (r < 128) { const int kv = r >> 6, d = r & 63; dbase[u] = (u16*)(ws + OFF_KGL); doff[u] = (size_t)((b * 2 + kv) * 4608 + 4096 + pp) * 64 + d; v[u] = p.cache_gqa_k[srow * 128 + r]; }
        else if (r < 256) { const int r2 = r - 128, kv = r2 >> 6, d = r2 & 63; dbase[u] = (u16*)(ws + OFF_VGL); doff[u] = (size_t)((b * 2 + kv) * 64 + d) * 4608 + 4096 + pp; v[u] = p.cache_gqa_v[srow * 128 + r2]; }
        else if (r < 768) { const int r2 = r - 256, hm = r2 >> 6, d = r2 & 63; dbase[u] = (u16*)(ws + OFF_KDL); doff[u] = (size_t)((b * 8 + hm) * 4608 + 4096 + pp) * 64 + d; v[u] = p.cache_diff_k[srow * 512 + r2]; }
        else { const int r2 = r - 768, h = r2 >> 7, e = r2 & 127; dbase[u] = (u16*)(ws + OFF_VDL); doff[u] = (size_t)((b * 4 + h) * 128 + e) * 4608 + 4096 + pp; v[u] = p.cache_diff_v[srow * 512 + r2]; }
    }
#pragma unroll
    for (int u = 0; u < 4; ++u) dbase[u][doff[u]] = f2bf(v[u]);
}

template <int RW = 4>
DEV void norm_item(const Params& p, int l, int which, int it, int tid) {
    const int lane = tid & 63, wid = __builtin_amdgcn_readfirstlane(tid >> 6);
    const int tb = it * (4 * RW) + wid * RW;
    const float* g = (which == 0 ? p.norm1 : p.norm2) + l * 1024;
    const float* mod = (const float*)(p.ws + OFF_MOD) + (size_t)(l * 3 + tok_cond(tb)) * 6144 + (which == 0 ? 0 : 3072);
    float4 v[RW][4];
#pragma unroll
    for (int r = 0; r < RW; ++r) {
        const int t = tb + r;
        if (which == 0 && l == 0) {
            const float* xr = t < 4096 ? p.x_prompt + (size_t)t * 1024 : p.x_sample + (size_t)(t - 4096) * 1024;
#pragma unroll
            for (int i = 0; i < 4; ++i) v[r][i] = *(const float4*)(xr + i * 256 + lane * 4);
        } else {
            const u16* xr = (const u16*)(p.ws + OFF_XB) + (size_t)t * 1024;
#pragma unroll
            for (int i = 0; i < 4; ++i) {
                const u32x2 w = *(const u32x2*)(xr + i * 256 + lane * 4);
                v[r][i] = make_float4(__uint_as_float(w.x << 16), __uint_as_float(w.x & 0xffff0000u), __uint_as_float(w.y << 16), __uint_as_float(w.y & 0xffff0000u));
            }
        }
    }
    float4 gg[4], sh[4], scv[4];
#pragma unroll
    for (int i = 0; i < 4; ++i) {
        const int e = i * 256 + lane * 4;
        gg[i] = *(const float4*)(g + e); sh[i] = *(const float4*)(mod + e); scv[i] = *(const float4*)(mod + 1024 + e);
        gg[i].x *= 1.f + scv[i].x; gg[i].y *= 1.f + scv[i].y; gg[i].z *= 1.f + scv[i].z; gg[i].w *= 1.f + scv[i].w;
    }
#pragma unroll
    for (int r = 0; r < RW; ++r) {
        float ss = 0.f;
#pragma unroll
        for (int i = 0; i < 4; ++i) ss += v[r][i].x * v[r][i].x + v[r][i].y * v[r][i].y + v[r][i].z * v[r][i].z + v[r][i].w * v[r][i].w;
#pragma unroll
        for (int o = 1; o < 64; o <<= 1) ss += __shfl_xor(ss, o);
        const float rstd = rsqrtf(ss * (1.0f / 1024.0f) + EPSV);
        u16* hr = (u16*)(p.ws + OFF_H) + (size_t)(tb + r) * 1024;
#pragma unroll
        for (int i = 0; i < 4; ++i) {
            const int e = i * 256 + lane * 4;
            const float a = v[r][i].x * rstd * gg[i].x + sh[i].x;
            const float b = v[r][i].y * rstd * gg[i].y + sh[i].y;
            const float c = v[r][i].z * rstd * gg[i].z + sh[i].z;
            const float d = v[r][i].w * rstd * gg[i].w + sh[i].w;
            *(u32x2*)(hr + e) = (u32x2){pack2(a, b), pack2(c, d)};
        }
    }
}

DEV void acc_to_rows(const f32x4 (&acc)[4][4], char* lds, int wid, int lane_in, float (&v)[64]) {
    int lane = lane_in;
    asm volatile("" : "+v"(lane));
    float* wt = (float*)(lds + wid * 16384);
    const int fr = lane & 15, fq = lane >> 4;
    int bj[4], bn[4];
#pragma unroll
    for (int j = 0; j < 4; ++j) bj[j] = fq * 256 + (fr ^ (4 * j)) + j * 64;
#pragma unroll
    for (int n = 0; n < 4; ++n) bn[n] = 16 * (n ^ fq);
#pragma unroll
    for (int m = 0; m < 4; ++m)
#pragma unroll
        for (int n = 0; n < 4; ++n)
#pragma unroll
            for (int j = 0; j < 4; ++j) wt[bj[j] + bn[n] + m * 1024] = acc[m][n][j];
    __syncthreads();
#pragma unroll
    for (int c4 = 0; c4 < 16; ++c4) {
        const float4 x = *(const float4*)(wt + lane * 64 + ((c4 ^ (lane & 15)) << 2));
        v[c4 * 4] = x.x; v[c4 * 4 + 1] = x.y; v[c4 * 4 + 2] = x.z; v[c4 * 4 + 3] = x.w;
    }
    __syncthreads();
}

DEV void row_norm_rope(float (&v)[64], const float* gain, bool rope, int n, const float* tab, float scale) {
    float ss = 0.f;
#pragma unroll
    for (int c = 0; c < 64; ++c) ss += v[c] * v[c];
    const float r = rsqrtf(ss * (1.0f / 64.0f) + EPSV);
#pragma unroll
    for (int c = 0; c < 64; ++c) v[c] = v[c] * r * gain[c];
    if (rope) {
        const int rp = n >> 6, cp = n & 63;
#pragma unroll
        for (int i = 0; i < 16; ++i) {
            const float2 a = *(const float2*)(tab + (rp * 16 + i) * 2);
            const float2 b = *(const float2*)(tab + (cp * 16 + i) * 2);
            const float x0 = v[i], x1 = v[16 + i], x2 = v[32 + i], x3 = v[48 + i];
            v[i] = x0 * a.x - x1 * a.y; v[16 + i] = x1 * a.x + x0 * a.y;
            v[32 + i] = x2 * b.x - x3 * b.y; v[48 + i] = x3 * b.x + x2 * b.y;
        }
    }
#pragma unroll
    for (int c = 0; c < 64; ++c) v[c] *= scale;
}
DEV void row_store_bf16(const float (&v)[64], u16* dst0, size_t ld, char* wl, int lane) {
#pragma unroll
    for (int i = 0; i < 8; ++i)
        *(u32x4*)(wl + lane * 128 + ((i ^ (lane & 7)) << 4)) = (u32x4){pack2(v[i * 8], v[i * 8 + 1]), pack2(v[i * 8 + 2], v[i * 8 + 3]), pack2(v[i * 8 + 4], v[i * 8 + 5]), pack2(v[i * 8 + 6], v[i * 8 + 7])};
    __builtin_amdgcn_wave_barrier();
    const int c = lane & 7;
#pragma unroll
    for (int i = 0; i < 8; ++i) {
        const int row = i * 8 + (lane >> 3);
        const u32x4 x = *(const u32x4*)(wl + row * 128 + ((c ^ (row & 7)) << 4));
        *(u32x4*)(dst0 + (size_t)row * ld + c * 8) = x;
    }
}
DEV void row_store_f32(const float (&v)[64], float* dst) {
#pragma unroll
    for (int i = 0; i < 16; ++i) *(float4*)(dst + i * 4) = make_float4(v[i * 4], v[i * 4 + 1], v[i * 4 + 2], v[i * 4 + 3]);
}
DEV void col_store_bf16(const float (&v)[64], u16* dst, size_t ld) {
#pragma unroll
    for (int c = 0; c < 64; ++c) dst[(size_t)c * ld] = f2bf(v[c]);
}

DEV void p1_tile(const Params& p, int l, int tile, char* lds, int tid) {
    char* ws = p.ws;
    const int tm = tile % 96, tn = tile / 96;
    const int lane = tid & 63, wid = __builtin_amdgcn_readfirstlane(tid >> 6), wr = wid >> 1, wc = wid & 1;
    float v[64];
    {
        f32x4 acc[4][4];
        zero_acc<4>(acc);
        gemm_mainloop<4>(acc, (const u16*)(ws + OFF_H) + (size_t)tm * 128 * 1024, 1024, (const u16*)(ws + OFF_WIN) + (size_t)tn * 128 * 1024, 1024, 1024, lds, tid);
        acc_to_rows(acc, lds, wid, lane, v);
    }
    const int t0 = tm * 128 + wr * 64;
    const bool lat = t0 >= 4096;
    const int bs = tok_bs(t0), n0 = tok_n(t0);
    const int t = t0 + lane, n = n0 + lane;
    char* wl = lds + wid * 16384;
    const float* tab = (const float*)(ws + OFF_ROPE);
    const int S = lat ? 4608 : 256;
    const int col = tn * 128 + wc * 64;
    if (tn < 4) {
        row_norm_rope(v, p.gqa_q_norm + l * 64, lat, n, tab, QSCALE);
        row_store_bf16(v, (u16*)(ws + OFF_QG) + (size_t)t0 * 512 + col, 512, wl, lane);
    } else if (tn == 4) {
        const int kv = wc;
        row_norm_rope(v, p.gqa_k_norm + l * 64, lat, n, tab, 1.0f);
        row_store_bf16(v, kg_ptr(ws, bs, kv) + (size_t)n0 * 64, 64, wl, lane);
        if (!lat) row_store_f32(v, p.out + OUT_GK + (size_t)((bs * 2 + l) * 256 + n) * 128 + kv * 64);
    } else if (tn == 5) {
        const int kv = wc;
        col_store_bf16(v, vgt_ptr(ws, bs, kv) + n, S);
        if (!lat) row_store_f32(v, p.out + OUT_GV + (size_t)((bs * 2 + l) * 256 + n) * 128 + kv * 64);
    } else if (tn < 8) {
#pragma unroll
        for (int c = 0; c < 64; ++c) v[c] *= 0.125f;
        row_store_bf16(v, (u16*)(ws + OFF_LQ) + (size_t)t0 * 256 + (col - 768), 256, wl, lane);
    } else if (tn < 10) {
        row_store_bf16(v, (u16*)(ws + OFF_LK) + (size_t)t0 * 256 + (col - 1024), 256, wl, lane);
    } else if (tn < 14) {
        const int c2 = col - 1280, h = c2 >> 7, e0 = c2 & 127;
        const int N = lat ? 4096 : 256;
        col_store_bf16(v, lvt_ptr(ws, bs, h) + (size_t)e0 * N + n, N);
    } else if (tn < 18) {
#pragma unroll
        for (int c = 0; c < 64; ++c) v[c] = siluf_(v[c]);
        row_store_bf16(v, (u16*)(ws + OFF_LGO) + (size_t)t0 * 512 + (col - 1792), 512, wl, lane);
    } else if (tn < 22) {
        row_norm_rope(v, p.diff_q_norm + l * 64, lat, n, tab, QSCALE);
        row_store_bf16(v, (u16*)(ws + OFF_QD) + (size_t)t0 * 512 + (col - 2304), 512, wl, lane);
    } else if (tn < 26) {
        const int hm = (col - 2816) >> 6;
        row_norm_rope(v, p.diff_k_norm + l * 64, lat, n, tab, 1.0f);
        row_store_bf16(v, kd_ptr(ws, bs, hm) + (size_t)n0 * 64, 64, wl, lane);
        if (!lat) row_store_f32(v, p.out + OUT_DK + (size_t)((bs * 2 + l) * 256 + n) * 512 + hm * 64);
    } else if (tn < 30) {
        const int c2 = col - 3328, h = c2 >> 7, e0 = c2 & 127;
        col_store_bf16(v, vdt_ptr(ws, bs, h) + (size_t)e0 * S + n, S);
        if (!lat) row_store_f32(v, p.out + OUT_DV + (size_t)((bs * 2 + l) * 256 + n) * 512 + c2);
    } else {
        if (wc == 0) {
            float* lr = (float*)(ws + OFF_LR) + (size_t)t * 32;
#pragma unroll
            for (int i = 0; i < 8; ++i) *(float4*)(lr + i * 4) = make_float4(v[i * 4], v[i * 4 + 1], v[i * 4 + 2], v[i * 4 + 3]);
        }
    }
    __syncthreads();
}

template <int DV>
DEV void attn_item(const u16* Qbase, int qcol, int trow0, const u16* Kp, const u16* VTp, int S, u16* Obase, int ostride, int ocol, char* lds, int tid) {
    const int lane = tid & 63, wid = __builtin_amdgcn_readfirstlane(tid >> 6), q = lane & 31, h = lane >> 5;
    constexpr int NDT = DV / 32;
    constexpr int KB = 64 * 128, VB = DV * 128;
    char* Kr = lds;
    char* Vr = lds + 3 * KB;
    bf16x8 qf[4];
#pragma unroll
    for (int ks = 0; ks < 4; ++ks) qf[ks] = *(const bf16x8*)(Qbase + (size_t)(trow0 + wid * 32 + q) * 512 + qcol + ks * 16 + h * 8);
    f32x16 o[NDT];
#pragma unroll
    for (int d = 0; d < NDT; ++d)
#pragma unroll
        for (int r = 0; r < 16; ++r) o[d][r] = 0.f;
    float m = 0.f, l = 0.f;
    float lo_thr = -8.0f;
    const int krow = (q & 19) | ((q & 4) << 1) | ((q & 8) >> 1);
    const int nt = S >> 6;
    auto qk = [&](f32x16 (&sc)[2], const char* kb) {
#pragma unroll
        for (int mt = 0; mt < 2; ++mt) {
            bf16x8 kf[4];
#pragma unroll
            for (int ks = 0; ks < 4; ++ks) kf[ks] = lds_frag1(kb, mt * 32 + krow, ks * 2 + h);
#pragma unroll
            for (int r = 0; r < 16; ++r) sc[mt][r] = 0.f;
#pragma unroll
            for (int ks = 0; ks < 4; ++ks) sc[mt] = mfma32(kf[ks], qf[ks], sc[mt]);
        }
    };
    auto step = [&](int it, f32x16 (&s)[2], f32x16 (&sn)[2]) {
        if (it > 0) { wait_vm0(); __syncthreads(); }
        if (it + 1 < nt) stage_rows<DV, 1>(VTp + (size_t)(it + 1) * 64, (unsigned)S, Vr + ((it + 1) & 1) * VB, tid);
        if (it + 2 < nt) stage_rows<64, 1>(Kp + (size_t)(it + 2) * 64 * 64, 64, Kr + ((it + 2) % 3) * KB, tid);
        qk(sn, Kr + ((it + 1) % 3) * KB);
        float mx = fmaxf(fmaxf(s[0][0], s[0][1]), s[0][2]);
#pragma unroll
        for (int r = 3; r < 15; r += 2) mx = fmaxf(fmaxf(mx, s[0][r]), s[0][r + 1]);
        mx = fmaxf(fmaxf(mx, s[0][15]), s[1][0]);
#pragma unroll
        for (int r = 1; r < 15; r += 2) mx = fmaxf(fmaxf(mx, s[1][r]), s[1][r + 1]);
        mx = fmaxf(mx, s[1][15]);
        mx = fmaxf(mx, __shfl_xor(mx, 32));
        const float rel = mx - m;
        const bool mv = rel > 8.0f || rel < lo_thr;
        lo_thr = -3.0e38f;
        if (__any(mv)) {
            const float delta = mv ? rel : 0.f;
            m += delta;
            const float alpha = delta > 0.f ? __builtin_amdgcn_exp2f(-delta) : 1.0f;
            l *= alpha;
#pragma unroll
            for (int d = 0; d < NDT; ++d) o[d] = o[d] * alpha;
        }
        if (__any(m != 0.f)) { s[0] = s[0] - m; s[1] = s[1] - m; }
#pragma unroll
        for (int mt = 0; mt < 2; ++mt)
#pragma unroll
            for (int r = 0; r < 16; ++r) s[mt][r] = __builtin_amdgcn_exp2f(s[mt][r]);
        {
            float a0 = s[0][0] + s[1][0], a1 = s[0][1] + s[1][1], a2 = s[0][2] + s[1][2], a3 = s[0][3] + s[1][3];
#pragma unroll
            for (int r = 4; r < 16; r += 4) { a0 += s[0][r] + s[1][r]; a1 += s[0][r + 1] + s[1][r + 1]; a2 += s[0][r + 2] + s[1][r + 2]; a3 += s[0][r + 3] + s[1][r + 3]; }
            l += (a0 + a1) + (a2 + a3);
        }
        bf16x8 pf[4];
#pragma unroll
        for (int kk = 0; kk < 4; ++kk) {
            const int mt = kk >> 1, t = (kk & 1) * 8;
            u32x4 w;
            w.x = pack2(s[mt][t], s[mt][t + 1]); w.y = pack2(s[mt][t + 2], s[mt][t + 3]);
            w.z = pack2(s[mt][t + 4], s[mt][t + 5]); w.w = pack2(s[mt][t + 6], s[mt][t + 7]);
            pf[kk] = __builtin_bit_cast(bf16x8, w);
        }
        asm volatile("" ::: "memory");
        const char* vb = Vr + (it & 1) * VB;
#pragma unroll
        for (int dt = 0; dt < NDT; ++dt) {
            bf16x8 vf[4];
#pragma unroll
            for (int kk = 0; kk < 4; ++kk) vf[kk] = lds_frag1(vb, dt * 32 + q, kk * 2 + h);
#pragma unroll
            for (int kk = 0; kk < 4; ++kk) o[dt] = mfma32(vf[kk], pf[kk], o[dt]);
        }
    };
    wait_vm0();
    stage_rows<64, 1>(Kp, 64, Kr, tid);
    stage_rows<DV, 1>(VTp, (unsigned)S, Vr, tid);
    stage_rows<64, 1>(Kp + (size_t)64 * 64, 64, Kr + KB, tid);
    wait_vm0();
    __syncthreads();
    f32x16 sa[2], sb[2];
    qk(sa, Kr);
    for (int it = 0; it < nt; it += 2) {
        step(it, sa, sb);
        step(it + 1, sb, sa);
    }
    __syncthreads();
    l += __shfl_xor(l, 32);
    const float inv = 1.0f / l;
    u16* orow = Obase + (size_t)(trow0 + wid * 32 + q) * ostride + ocol + 4 * h;
#pragma unroll
    for (int d = 0; d < NDT; ++d)
#pragma unroll
        for (int g = 0; g < 4; ++g)
            *(u32x2*)(orow + 32 * d + 8 * g) = (u32x2){pack2(o[d][4 * g] * inv, o[d][4 * g + 1] * inv), pack2(o[d][4 * g + 2] * inv, o[d][4 * g + 3] * inv)};
}

DEV void gla1_item(const Params& p, int l, int it, char* lds, int tid) {
    char* ws = p.ws;
    const int gch = it >> 2, h = it & 3;
    const int t0 = gch * 64;
    const int bs = tok_bs(t0), n0 = tok_n(t0);
    const int N = bs < 16 ? 256 : 4096;
    const int lane = tid & 63, wid = __builtin_amdgcn_readfirstlane(tid >> 6), fr = lane & 15, fq = lane >> 4;
    float* lrS = (float*)lds;
    char* vT = lds + 8192;
    char* Qd = lds + 24576;
    char* Ki = lds + 32768;
    char* KteT = lds + 40960;
    char* Am = lds + 49152;
    float* tot = (float*)(lds + 57344);
    stage_rows<128>(lvt_ptr(ws, bs, h) + n0, (unsigned)N, vT, tid);
    const int d = tid & 63, qt = __builtin_amdgcn_readfirstlane(tid >> 6);
    float4 lr0, lr1;
    {
        const float4* src = (const float4*)((const float*)(ws + OFF_LR) + (size_t)t0 * 32);
        lr0 = src[tid]; lr1 = src[tid + 256];
    }
    u16 qraw[16], kraw[16];
#pragma unroll
    for (int jj = 0; jj < 16; ++jj) {
        const size_t gi = (size_t)(t0 + qt * 16 + jj) * 256 + h * 64 + d;
        qraw[jj] = ((const u16*)(ws + OFF_LQ))[gi];
        kraw[jj] = ((const u16*)(ws + OFF_LK))[gi];
    }
    float up[16], upn[16];
#pragma unroll
    for (int r = 0; r < 16; ++r) up[r] = p.gla_alpha_up[((size_t)(l * 2) * 16 + r) * 256 + h * 64 + d];
    float bias = p.gla_alpha_bias[(l * 2) * 256 + h * 64 + d], biasn;
    ((float4*)lrS)[tid] = lr0;
    ((float4*)lrS)[tid + 256] = lr1;
    wait_vm0();
    __syncthreads();
    f32x4 oacc[8];
#pragma unroll
    for (int n = 0; n < 8; ++n) oacc[n] = (f32x4){0.f, 0.f, 0.f, 0.f};
#pragma unroll 1
    for (int dir = 0; dir < 2; ++dir) {
        const int cc = (gch * 4 + h) * 2 + dir;
#pragma unroll
        for (int r = 0; r < 16; ++r) upn[r] = p.gla_alpha_up[((size_t)(l * 2 + 1) * 16 + r) * 256 + h * 64 + d];
        biasn = p.gla_alpha_bias[(l * 2 + 1) * 256 + h * 64 + d];
        float la[16];
        float run = 0.f;
#pragma unroll
        for (int jj = 0; jj < 16; ++jj) {
            const float4* lp = (const float4*)(lrS + (qt * 16 + jj) * 32 + dir * 16);
            float z = bias;
#pragma unroll
            for (int r4 = 0; r4 < 4; ++r4) { const float4 x = lp[r4]; z += x.x * up[r4 * 4] + x.y * up[r4 * 4 + 1] + x.z * up[r4 * 4 + 2] + x.w * up[r4 * 4 + 3]; }
            la[jj] = (fminf(z, 0.f) - __logf(1.0f + __expf(-fabsf(z)))) * (1.0f / 16.0f);
            run += la[jj];
            asm volatile("" ::: "memory");
        }
        tot[qt * 64 + d] = run;
        __syncthreads();
        float offs = 0.f, total = 0.f;
#pragma unroll
        for (int q2 = 0; q2 < 4; ++q2) {
            const float tv = tot[q2 * 64 + d];
            total += tv;
            if (dir == 0 ? (q2 < qt) : (q2 > qt)) offs += tv;
        }
        float cpre = dir == 0 ? offs : offs + run;
#pragma unroll
        for (int j4 = 0; j4 < 4; ++j4) {
            float kt4[4];
#pragma unroll
            for (int u = 0; u < 4; ++u) {
                const int jj = j4 * 4 + u;
                const int j = qt * 16 + jj;
                float cv;
                if (dir == 0) { cpre += la[jj]; cv = cpre; } else { cv = cpre; cpre -= la[jj]; }
                const float qv = bf2f(qraw[jj]);
                const float kv = bf2f(kraw[jj]);
                const u16 qd = f2bf(qv * __expf(cv));
                const u16 ki = f2bf(kv * __expf(-cv));
                kt4[u] = kv * __expf(total - cv);
                const int so = j * 128 + ((((d >> 3) ^ (j & 7))) << 4) + (d & 7) * 2;
                *(u16*)(Qd + so) = qd;
                *(u16*)(Ki + so) = ki;
                ((u16*)(ws + OFF_QDG))[(size_t)dir * NTOK * 256 + (size_t)(t0 + j) * 256 + h * 64 + d] = qd;
                asm volatile("" ::: "memory");
            }
            const int j0 = qt * 16 + j4 * 4;
            *(u32x2*)(KteT + d * 128 + ((((j0 >> 3) ^ (d & 7))) << 4) + (j0 & 4) * 2) = (u32x2){pack2(kt4[0], kt4[1]), pack2(kt4[2], kt4[3])};
        }
        if (qt == 0) ((float*)(ws + OFF_DECAY))[(size_t)cc * 64 + d] = __expf(total);
        __syncthreads();
        {
            f32x4 sacc[4];
#pragma unroll
            for (int n = 0; n < 4; ++n) sacc[n] = (f32x4){0.f, 0.f, 0.f, 0.f};
#pragma unroll
            for (int ks = 0; ks < 2; ++ks) {
                const bf16x8 a = lds_frag(Qd, wid * 16 + fr, ks * 4 + fq);
#pragma unroll
                for (int n = 0; n < 4; ++n) sacc[n] = mfma16(a, lds_frag(Ki, n * 16 + fr, ks * 4 + fq), sacc[n]);
            }
#pragma unroll
            for (int n = 0; n < 4; ++n)
#pragma unroll
                for (int r = 0; r < 4; ++r) {
                    const int i = wid * 16 + fq * 4 + r, j = n * 16 + fr;
                    const bool keep = dir == 0 ? (j <= i) : (j >= i);
                    *(u16*)(Am + i * 128 + ((((j >> 3) ^ (i & 7))) << 4) + (j & 7) * 2) = keep ? f2bf(sacc[n][r]) : (u16)0;
                }
            f32x4 dacc[2][4];
#pragma unroll
            for (int mt = 0; mt < 2; ++mt)
#pragma unroll
                for (int n = 0; n < 4; ++n) dacc[mt][n] = (f32x4){0.f, 0.f, 0.f, 0.f};
#pragma unroll
            for (int ks = 0; ks < 2; ++ks) {
                bf16x8 b[4];
#pragma unroll
                for (int n = 0; n < 4; ++n) b[n] = lds_frag(KteT, n * 16 + fr, ks * 4 + fq);
#pragma unroll
                for (int mt = 0; mt < 2; ++mt) {
                    const bf16x8 a = lds_frag(vT, wid * 32 + mt * 16 + fr, ks * 4 + fq);
#pragma unroll
                    for (int n = 0; n < 4; ++n) dacc[mt][n] = mfma16(a, b[n], dacc[mt][n]);
                }
            }
            u16* dst = (u16*)(ws + OFF_DST) + (size_t)cc * 8192;
#pragma unroll
            for (int mt = 0; mt < 2; ++mt)
#pragma unroll
                for (int n = 0; n < 4; ++n)
#pragma unroll
                    for (int r = 0; r < 4; ++r) dst[(wid * 32 + mt * 16 + fq * 4 + r) * 64 + n * 16 + fr] = f2bf(dacc[mt][n][r]);
        }
        __syncthreads();
#pragma unroll
        for (int ks = 0; ks < 2; ++ks) {
            const bf16x8 a = lds_frag(Am, wid * 16 + fr, ks * 4 + fq);
#pragma unroll
            for (int n = 0; n < 8; ++n) oacc[n] = mfma16(a, lds_frag(vT, n * 16 + fr, ks * 4 + fq), oacc[n]);
        }
        __syncthreads();
#pragma unroll
        for (int r = 0; r < 16; ++r) up[r] = upn[r];
        bias = biasn;
    }
    u32x2* oi = (u32x2*)(ws + OFF_OI) + ((size_t)it * 4 + wid) * 8 * 64;
#pragma unroll
    for (int n = 0; n < 8; ++n) oi[n * 64 + lane] = (u32x2){pack2(oacc[n][0], oacc[n][1]), pack2(oacc[n][2], oacc[n][3])};
}

DEV void scan_item(const Params& p, int l, int it, int tid) {
    char* ws = p.ws;
    const u16* __restrict__ dst = (const u16*)(ws + OFF_DST);
    u16* __restrict__ sp = (u16*)(ws + OFF_SPREV);
    const float* __restrict__ dec = (const float*)(ws + OFF_DECAY);
    const int d = tid & 63, wv = __builtin_amdgcn_readfirstlane(tid >> 6);
    if (it < 512) {
        const int bs = 16 + (it >> 8), rem = it & 255;
        const int h = rem >> 6, dir = (rem >> 5) & 1, eb = rem & 31;
        const int e = eb * 4 + wv;
        const int gbase = 64 + (bs - 16) * 64;
        float s = p.state_gla[((size_t)((((bs - 16) * 2 + l) * 2 + dir) * 4 + h)) * 8192 + d * 128 + e];
#pragma unroll 1
        for (int st0 = 0; st0 < 64; st0 += 32) {
            float dv[32], xv[32];
#pragma unroll
            for (int u = 0; u < 32; ++u) {
                const int c = dir == 0 ? st0 + u : 63 - (st0 + u);
                const size_t ci = (size_t)((gbase + c) * 4 + h) * 2 + dir;
                dv[u] = dec[ci * 64 + d];
                xv[u] = bf2f(dst[ci * 8192 + e * 64 + d]);
            }
#pragma unroll
            for (int u = 0; u < 32; ++u) {
                const int c = dir == 0 ? st0 + u : 63 - (st0 + u);
                const size_t ci = (size_t)((gbase + c) * 4 + h) * 2 + dir;
                sp[ci * 8192 + e * 64 + d] = f2bf(s); s = dv[u] * s + xv[u];
            }
        }
    } else {
        const int i2 = it - 512, bs = i2 >> 5, rem = i2 & 31;
        const int h = rem >> 3, dir = (rem >> 2) & 1, eq = rem & 3;
        float dv[4];
        size_t cidx[4];
#pragma unroll
        for (int st = 0; st < 4; ++st) {
            const int c = dir == 0 ? st : 3 - st;
            cidx[st] = (size_t)((bs * 4 + c) * 4 + h) * 2 + dir;
            dv[st] = dec[cidx[st] * 64 + d];
        }
        float xv[8][4];
#pragma unroll
        for (int u = 0; u < 8; ++u)
#pragma unroll
            for (int st = 0; st < 4; ++st) xv[u][st] = bf2f(dst[cidx[st] * 8192 + ((eq * 8 + u) * 4 + wv) * 64 + d]);
#pragma unroll
        for (int u = 0; u < 8; ++u) {
            const int e = (eq * 8 + u) * 4 + wv;
            float s = 0.f;
#pragma unroll
            for (int st = 0; st < 4; ++st) { sp[cidx[st] * 8192 + e * 64 + d] = f2bf(s); s = dv[st] * s + xv[u][st]; }
            p.out[OUT_ST + ((size_t)(((bs * 2 + l) * 2 + dir) * 4 + h)) * 8192 + d * 128 + e] = s;
        }
    }
}

DEV void gla3_item(const Params& p, int l, int it, int tid) {
    char* ws = p.ws;
    const int gch = it >> 2, h = it & 3;
    const int t0 = gch * 64;
    const int lane = tid & 63, wid = __builtin_amdgcn_readfirstlane(tid >> 6), fr = lane & 15, fq = lane >> 4;
    f32x4 acc[8];
    const u32x2* oi = (const u32x2*)(ws + OFF_OI) + ((size_t)it * 4 + wid) * 8 * 64;
#pragma unroll
    for (int n = 0; n < 8; ++n) {
        const u32x2 w = oi[n * 64 + lane];
        acc[n] = (f32x4){__uint_as_float(w.x << 16), __uint_as_float(w.x & 0xffff0000u), __uint_as_float(w.y << 16), __uint_as_float(w.y & 0xffff0000u)};
    }
#pragma unroll
    for (int dir = 0; dir < 2; ++dir) {
        const size_t cc = (size_t)(gch * 4 + h) * 2 + dir;
        const u16* qd = (const u16*)(ws + OFF_QDG) + (size_t)dir * NTOK * 256 + (size_t)(t0 + wid * 16 + fr) * 256 + h * 64;
        const u16* sp = (const u16*)(ws + OFF_SPREV) + cc * 8192;
#pragma unroll
        for (int ks = 0; ks < 2; ++ks) {
            const bf16x8 a = *(const bf16x8*)(qd + ks * 32 + fq * 8);
#pragma unroll
            for (int n = 0; n < 8; ++n) {
                const bf16x8 b = *(const bf16x8*)(sp + (n * 16 + fr) * 64 + ks * 32 + fq * 8);
                acc[n] = mfma16(a, b, acc[n]);
            }
        }
    }
    float gn[8];
#pragma unroll
    for (int n = 0; n < 8; ++n) gn[n] = p.gla_out_norm[l * 128 + n * 16 + fr];
#pragma unroll
    for (int r = 0; r < 4; ++r) {
        float ss = 0.f;
#pragma unroll
        for (int n = 0; n < 8; ++n) ss += acc[n][r] * acc[n][r];
        ss += __shfl_xor(ss, 1); ss += __shfl_xor(ss, 2); ss += __shfl_xor(ss, 4); ss += __shfl_xor(ss, 8);
        const float rstd = rsqrtf(ss * (1.0f / 128.0f) + EPSV);
        const size_t t = (size_t)(t0 + wid * 16 + fq * 4 + r);
        const u16* g = (const u16*)(ws + OFF_LGO) + t * 512 + h * 128;
        u16* o = (u16*)(ws + OFF_GLAOUT) + t * 512 + h * 128;
#pragma unroll
        for (int n = 0; n < 8; ++n) o[n * 16 + fr] = f2bf(acc[n][r] * rstd * gn[n] * bf2f(g[n * 16 + fr]));
    }
}

DEV float diff_lambda_val(const Params& p, int l, int lane) {
    const float* lp = p.diff_lambda + l * 256;
    float a = lp[lane] * lp[64 + lane], b = lp[128 + lane] * lp[192 + lane];
#pragma unroll
    for (int o = 1; o < 64; o <<= 1) { a += __shfl_xor(a, o); b += __shfl_xor(b, o); }
    const float lam_init = l == 0 ? 0.2f : (0.8f - 0.6f * 0.7408182206817179f);
    return __expf(a) - __expf(b) + lam_init;
}

DEV void diffc_item(const Params& p, int l, int it, int tid) {
    char* ws = p.ws;
    const int lane = tid & 63, wid = __builtin_amdgcn_readfirstlane(tid >> 6);
    const float lam = diff_lambda_val(p, l, lane);
    const float lam_init = l == 0 ? 0.2f : (0.8f - 0.6f * 0.7408182206817179f);
    const float g0 = p.diff_sub_norm[l * 128 + 2 * lane] * (1.0f - lam_init), g1 = p.diff_sub_norm[l * 128 + 2 * lane + 1] * (1.0f - lam_init);
    unsigned w1[24], w2[24];
#pragma unroll
    for (int i = 0; i < 24; ++i) {
        const int row = it * 96 + wid * 24 + i;
        const int t = row >> 2, h = row & 3;
        w1[i] = *(const unsigned*)((const u16*)(ws + OFF_DIFFO) + (size_t)t * 1024 + (h * 2) * 128 + 2 * lane);
        w2[i] = *(const unsigned*)((const u16*)(ws + OFF_DIFFO) + (size_t)t * 1024 + (h * 2 + 1) * 128 + 2 * lane);
    }
#pragma unroll
    for (int i = 0; i < 24; ++i) {
        const int row = it * 96 + wid * 24 + i;
        const int t = row >> 2, h = row & 3;
        const float a0 = __uint_as_float(w1[i] << 16) - lam * __uint_as_float(w2[i] << 16);
        const float a1 = __uint_as_float(w1[i] & 0xffff0000u) - lam * __uint_as_float(w2[i] & 0xffff0000u);
        float ss = a0 * a0 + a1 * a1;
#pragma unroll
        for (int o = 1; o < 64; o <<= 1) ss += __shfl_xor(ss, o);
        const float rstd = rsqrtf(ss * (1.0f / 128.0f) + EPSV);
        *(unsigned*)((u16*)(ws + OFF_DIFFOUT) + (size_t)t * 512 + h * 128 + 2 * lane) = pack2(a0 * rstd * g0, a1 * rstd * g1);
    }
}

DEV void p5_tile(const Params& p, int l, int tile, char* lds, int tid) {
    char* ws = p.ws;
    const int xk = tile >> 3, tm = (tile & 7) * 12 + (xk >> 4), tn = xk & 15;
    const int lane = tid & 63, wid = __builtin_amdgcn_readfirstlane(tid >> 6), wr = wid >> 1, wc = wid & 1, fr = lane & 15, fq = lane >> 4;
    f32x4 tot[4][2];
    zero_acc<2>(tot);
    for (int i = 0; i < 3; ++i) {
        f32x4 g[4][2];
        zero_acc<2>(g);
        gemm_mainloop<2, true>(g, (const u16*)(ws + OFF_H) + (size_t)tm * 128 * 1024, 1024, (const u16*)(ws + OFF_WIN) + (size_t)(3968 + i * 1024 + tn * 64) * 1024, 1024, 1024, lds, tid);
#pragma unroll
        for (int m = 0; m < 4; ++m)
#pragma unroll
            for (int n = 0; n < 2; ++n)
#pragma unroll
                for (int j = 0; j < 4; ++j) g[m][n][j] = sigmoidf_(g[m][n][j]);
        f32x4 y[4][2];
        zero_acc<2>(y);
        const u16* bo = (const u16*)(ws + (i == 0 ? OFF_QG : (i == 1 ? OFF_GLAOUT : OFF_DIFFOUT)));
        gemm_mainloop<2, true>(y, bo + (size_t)tm * 128 * 512, 512, (const u16*)(ws + OFF_WBR) + (size_t)(i * 1024 + tn * 64) * 512, 512, 512, lds, tid);
#pragma unroll
        for (int m = 0; m < 4; ++m)
#pragma unroll
            for (int n = 0; n < 2; ++n) tot[m][n] = tot[m][n] + g[m][n] * y[m][n];
    }
    u16* dst = (u16*)(ws + OFF_MIXED) + (size_t)(tm * 128 + wr * 64 + fr) * 1024 + tn * 64 + wc * 32 + fq * 4;
#pragma unroll
    for (int m = 0; m < 4; ++m)
#pragma unroll
        for (int n = 0; n < 2; ++n)
            *(u32x2*)(dst + (size_t)m * 16 * 1024 + n * 16) = (u32x2){pack2(tot[m][n][0], tot[m][n][1]), pack2(tot[m][n][2], tot[m][n][3])};
}

DEV void resid_tile(const Params& p, int l, int which, int tile, char* lds, int tid, int fuse) {
    char* ws = p.ws;
    const int xk = tile >> 3, tm = (tile & 7) * 12 + (xk >> 4), tn = xk & 15;
    const int lane = tid & 63, wid = __builtin_amdgcn_readfirstlane(tid >> 6), wr = wid >> 1, wc = wid & 1, fr = lane & 15, fq = lane >> 4;
    f32x4 acc[4][2];
    zero_acc<2>(acc);
    if (which == 0) gemm_mainloop3<2, true>(acc, (const u16*)(ws + OFF_MIXED) + (size_t)tm * 128 * 1024, 1024, (const u16*)(ws + OFF_WOUT) + (size_t)tn * 64 * 1024, 1024, 1024, lds, tid);
    else gemm_mainloop3<2, true>(acc, (const u16*)(ws + OFF_ACT) + (size_t)tm * 128 * FFH, FFH, (const u16*)(ws + OFF_WFO) + (size_t)tn * 64 * FFH, FFH, FFH, lds, tid);
    const int t0 = tm * 128 + wr * 64;
    const float* gate = (const float*)(ws + OFF_MOD) + (size_t)(l * 3 + tok_cond(t0)) * 6144 + (which == 0 ? 2048 : 5120);
    const int c0 = tn * 64 + wc * 32 + fq * 4;
    float4 gv[2];
    gv[0] = *(const float4*)(gate + c0); gv[1] = *(const float4*)(gate + c0 + 16);
#pragma unroll
    for (int m = 0; m < 4; ++m) {
        const int t = t0 + m * 16 + fr;
        const bool in_f32 = (which == 0 && l == 0);
        const bool out_f32 = (which == 1 && l == 1);
        const float* xin = t < 4096 ? p.x_prompt + (size_t)t * 1024 : p.x_sample + (size_t)(t - 4096) * 1024;
        u16* xb = (u16*)(ws + OFF_XB) + (size_t)t * 1024;
        float* xo = p.out + (size_t)t * 1024;
#pragma unroll
        for (int n = 0; n < 2; ++n) {
            float4 xi;
            if (in_f32) xi = *(const float4*)(xin + c0 + n * 16);
            else {
                const u32x2 w = *(const u32x2*)(xb + c0 + n * 16);
                xi = make_float4(__uint_as_float(w.x << 16), __uint_as_float(w.x & 0xffff0000u), __uint_as_float(w.y << 16), __uint_as_float(w.y & 0xffff0000u));
            }
            f32x4 v;
            v[0] = xi.x + gv[n].x * acc[m][n][0]; v[1] = xi.y + gv[n].y * acc[m][n][1]; v[2] = xi.z + gv[n].z * acc[m][n][2]; v[3] = xi.w + gv[n].w * acc[m][n][3];
            if (out_f32) *(f32x4*)(xo + c0 + n * 16) = v;
            else *(u32x2*)(xb + c0 + n * 16) = (u32x2){pack2(v[0], v[1]), pack2(v[2], v[3])};
        }
    }
    if (fuse >= 0) {
        volatile LAS unsigned* flag = (volatile LAS unsigned*)(lds + 73728 + 8);
        asm volatile("s_waitcnt vmcnt(0)" ::: "memory");
        __syncthreads();
        if (tid == 0) {
            const unsigned old = __hip_atomic_fetch_add((unsigned*)(ws + OFF_CNT) + fuse * 128 + tm, 1u, __ATOMIC_RELAXED, __HIP_MEMORY_SCOPE_AGENT);
            const unsigned last = (old == 15u) ? 1u : 0u;
            if (last) { __builtin_amdgcn_fence(__ATOMIC_ACQUIRE, "agent"); asm volatile("s_waitcnt vmcnt(0)" ::: "memory"); }
            flag[0] = last;
        }
        __syncthreads();
        const unsigned last = flag[0];
        if (last) {
#pragma unroll 1
            for (int i = 0; i < 4; ++i) {
                if (which == 0) norm_item<8>(p, l, 1, tm * 4 + i, tid);
                else norm_item<8>(p, l + 1, 0, tm * 4 + i, tid);
            }
        }
        __syncthreads();
    }
}

DEV void p8_tile(const Params& p, int l, int tile, char* lds, int tid, int rep = 0) {
    char* ws = p.ws;
    const int tm = tile % 96, tn = tile / 96;
    const int lane = tid & 63, wid = __builtin_amdgcn_readfirstlane(tid >> 6), wr = wid >> 1, wc = wid & 1, fr = lane & 15, fq = lane >> 4;
    f32x4 acc[4][4];
    zero_acc<4>(acc);
    gemm_mainloop<4, true>(acc, (const u16*)(ws + OFF_H) + (size_t)tm * 128 * 1024, 1024, (const u16*)(ws + OFF_WFI) + (size_t)tn * 128 * 1024, 1024, 1024, lds, tid);
    u16* dst = (u16*)(ws + OFF_ACT) + (size_t)(tm * 128 + wr * 64 + fr) * FFH + tn * 64 + wc * 32 + fq * 4;
#pragma unroll
    for (int m = 0; m < 4; ++m)
#pragma unroll
        for (int n = 0; n < 2; ++n) {
            const f32x4 a = acc[m][n], u = acc[m][n + 2];
            *(u32x2*)(dst + (size_t)m * 16 * FFH + n * 16) = (u32x2){pack2(siluf_(a[0]) * u[0], siluf_(a[1]) * u[1]), pack2(siluf_(a[2]) * u[2], siluf_(a[3]) * u[3])};
        }
}

DEV void p5_phase(const Params& p, int l, char* lds) {
    char* ws = p.ws;
    const int nitems = 96 * 16;
    int par = 0; int pre = 0;
    for (int it = blockIdx.x; it < nitems; it += gridDim.x) {
        int tid = threadIdx.x;
        asm volatile("" : "+v"(tid));
        const int lane = tid & 63, wid = __builtin_amdgcn_readfirstlane(tid >> 6), wr = wid >> 1, wc = wid & 1, fr = lane & 15, fq = lane >> 4;
        const int xk = it >> 3, tm = (it & 7) * 12 + (xk >> 4), tn = xk & 15;
        const int nit = it + gridDim.x; const bool hn = nit < nitems;
        const int nxk = nit >> 3, ntm = (nit & 7) * 12 + (nxk >> 4), ntn = nxk & 15;
        const u16* Hp = (const u16*)(ws + OFF_H);
        const u16* Wg = (const u16*)(ws + OFF_WIN) + (size_t)3968 * 1024;
        const u16* Wb = (const u16*)(ws + OFF_WBR);
        f32x4 tot[4][2];
        zero_acc<2>(tot);
#pragma unroll 1
        for (int i = 0; i < 3; ++i) {
            const u16* bo = (const u16*)(ws + (i == 0 ? OFF_QG : (i == 1 ? OFF_GLAOUT : OFF_DIFFOUT)));
            const u16* gA = Hp + (size_t)tm * 128 * 1024, *gB = Wg + (size_t)(i * 1024 + tn * 64) * 1024;
            const u16* yA = bo + (size_t)tm * 128 * 512, *yB = Wb + (size_t)(i * 1024 + tn * 64) * 512;
            f32x4 g[4][2];
            zero_acc<2>(g);
            gemm_chain2<2, true>(g, gA, 1024, gB, 1024, 1024, true, yA, 512, yB, 512, par, pre, lds, tid);
#pragma unroll
            for (int m = 0; m < 4; ++m)
#pragma unroll
                for (int n = 0; n < 2; ++n)
#pragma unroll
                    for (int j = 0; j < 4; ++j) g[m][n][j] = sigmoidf_(g[m][n][j]);
            const bool hx = i < 2 ? true : hn;
            const u16* xA = i < 2 ? gA : Hp + (size_t)ntm * 128 * 1024;
            const u16* xB = i < 2 ? Wg + (size_t)((i + 1) * 1024 + tn * 64) * 1024 : Wg + (size_t)(ntn * 64) * 1024;
            f32x4 y[4][2];
            zero_acc<2>(y);
            gemm_chain2<2, true>(y, yA, 512, yB, 512, 512, hx, xA, 1024, xB, 1024, par, pre, lds, tid);
#pragma unroll
            for (int m = 0; m < 4; ++m)
#pragma unroll
                for (int n = 0; n < 2; ++n) tot[m][n] = tot[m][n] + g[m][n] * y[m][n];
        }
        u16* dst = (u16*)(ws + OFF_MIXED) + (size_t)(tm * 128 + wr * 64 + fr) * 1024 + tn * 64 + wc * 32 + fq * 4;
#pragma unroll
        for (int m = 0; m < 4; ++m)
#pragma unroll
            for (int n = 0; n < 2; ++n)
                *(u32x2*)(dst + (size_t)m * 16 * 1024 + n * 16) = (u32x2){pack2(tot[m][n][0], tot[m][n][1]), pack2(tot[m][n][2], tot[m][n][3])};
    }
}

DEV void p8_phase(const Params& p, int l, char* lds) {
    char* ws = p.ws;
    const int nitems = 96 * 44;
    int par = 0; int pre = 0;
    for (int it = blockIdx.x; it < nitems; it += gridDim.x) {
        int tid = threadIdx.x;
        asm volatile("" : "+v"(tid));
        const int lane = tid & 63, wid = __builtin_amdgcn_readfirstlane(tid >> 6), wr = wid >> 1, wc = wid & 1, fr = lane & 15, fq = lane >> 4;
        const int tm = it % 96, tn = it / 96;
        const int nit = it + gridDim.x; const bool hn = nit < nitems;
        const int ntm = nit % 96, ntn = nit / 96;
        f32x4 acc[4][4];
        zero_acc<4>(acc);
        gemm_chain2<4, true>(acc, (const u16*)(ws + OFF_H) + (size_t)tm * 128 * 1024, 1024, (const u16*)(ws + OFF_WFI) + (size_t)tn * 128 * 1024, 1024, 1024,
                            hn, (const u16*)(ws + OFF_H) + (size_t)ntm * 128 * 1024, 1024, (const u16*)(ws + OFF_WFI) + (size_t)ntn * 128 * 1024, 1024, par, pre, lds, tid);
        u16* dst = (u16*)(ws + OFF_ACT) + (size_t)(tm * 128 + wr * 64 + fr) * FFH + tn * 64 + wc * 32 + fq * 4;
#pragma unroll
        for (int m = 0; m < 4; ++m)
#pragma unroll
            for (int n = 0; n < 2; ++n) {
                const f32x4 a = acc[m][n], u = acc[m][n + 2];
                *(u32x2*)(dst + (size_t)m * 16 * FFH + n * 16) = (u32x2){pack2(siluf_(a[0]) * u[0], siluf_(a[1]) * u[1]), pack2(siluf_(a[2]) * u[2], siluf_(a[3]) * u[3])};
            }
    }
    if (l == 0) {
        const int rem = nitems % (int)gridDim.x;
        const int first = rem == 0 ? 0 : rem, nidle = (int)gridDim.x - first;
        if ((int)blockIdx.x >= first)
            for (int j = (int)blockIdx.x - first; j < NCONV_EARLY; j += nidle) {
                int tid = threadIdx.x;
                asm volatile("" : "+v"(tid));
                conv_item(p, 1, j, lds, tid);
            }
    }
}

DEV void p2_phase(const Params& p, int l, char* lds) {
    char* ws = p.ws;
    for (int it = blockIdx.x; it < 1024; it += gridDim.x) {
        int tid = threadIdx.x;
        asm volatile("" : "+v"(tid));
        if (it < 512) {
            const int j = it & 7, r = it >> 3, b = j >> 2, hm = (j & 3) * 2 + (r >> 5), qb = r & 31, bs = 16 + b;
            attn_item<128>((const u16*)(ws + OFF_QD), hm * 64, 4096 + b * 4096 + qb * 128, kd_ptr(ws, bs, hm), vdt_ptr(ws, bs, hm >> 1), 4608, (u16*)(ws + OFF_DIFFO), 1024, hm * 128, lds, tid);
        } else {
            const int i2 = it - 512, j = i2 & 7, r = i2 >> 3, b = j >> 2, kvh = (j >> 1) & 1, hh = kvh * 4 + (j & 1) * 2 + (r >> 5), qb = r & 31, bs = 16 + b;
            attn_item<64>((const u16*)(ws + OFF_QG), hh * 64, 4096 + b * 4096 + qb * 128, kg_ptr(ws, bs, hh >> 2), vgt_ptr(ws, bs, hh >> 2), 4608, (u16*)(ws + OFF_QG), 512, hh * 64, lds, tid);
        }
    }
    volatile LAS unsigned* flag = (volatile LAS unsigned*)(lds + 73728 + 8);
    unsigned* cnt = (unsigned*)(ws + OFF_CNT) + l * 64;
    for (;;) {
        int tid = threadIdx.x;
        asm volatile("" : "+v"(tid));
        __syncthreads();
        if (tid == 0) flag[0] = __hip_atomic_fetch_add(cnt, 1u, __ATOMIC_RELAXED, __HIP_MEMORY_SCOPE_AGENT);
        __syncthreads();
        const int j = __builtin_amdgcn_readfirstlane((int)flag[0]);
        if (j >= 1280) break;
        if (j < 768) gla1_item(p, l, j, lds, tid);
        else {
            const int i2 = j - 768, bs = i2 >> 5, ty = (i2 >> 4) & 1, hh = (i2 >> 1) & 7, qb = i2 & 1;
            if (ty == 0) attn_item<128>((const u16*)(ws + OFF_QD), hh * 64, bs * 256 + qb * 128, kd_ptr(ws, bs, hh), vdt_ptr(ws, bs, hh >> 1), 256, (u16*)(ws + OFF_DIFFO), 1024, hh * 128, lds, tid);
            else attn_item<64>((const u16*)(ws + OFF_QG), hh * 64, bs * 256 + qb * 128, kg_ptr(ws, bs, hh >> 2), vgt_ptr(ws, bs, hh >> 2), 256, (u16*)(ws + OFF_QG), 512, hh * 64, lds, tid);
        }
    }
}

#define XB_TMO      128
#define XB_XCNT(j)  (256  + 64 * (j))
#define XB_XSUB(j)  (1280 + 64 * (j))
#define XB_XGEN(j)  (2304 + 64 * (j))
#define XB_TOP      3328
#define XB_TOPGEN   3392
#define XCD_BAR_WORDS 3456
#define XB_SPIN_CAP (1u << 22)
DEV unsigned xb_ld(unsigned* p) { return __hip_atomic_load(p, __ATOMIC_RELAXED, __HIP_MEMORY_SCOPE_AGENT); }
DEV unsigned xb_add(unsigned* p, unsigned v) { return __hip_atomic_fetch_add(p, v, __ATOMIC_RELAXED, __HIP_MEMORY_SCOPE_AGENT); }
DEV unsigned xb_xcc_id() { return (unsigned)__builtin_amdgcn_s_getreg((3 << 11) | 20) & 0xFu; }
#define XB_SPIN(cond, bar) do { unsigned _sp = 0; while (cond) { __builtin_amdgcn_s_sleep(1); \
    if ((++_sp & 255u) == 0u) { if (xb_ld(&(bar)[XB_TMO])) break; if (_sp > XB_SPIN_CAP) { atomicAdd(&(bar)[XB_TMO], 1u); break; } } } } while (0)
struct XcdBarrier { unsigned* bar; unsigned x; volatile LAS unsigned* st; };
DEV XcdBarrier xcd_barrier_post(unsigned* bar, volatile LAS unsigned* st) {
    XcdBarrier b; b.bar = bar; b.x = xb_xcc_id(); b.st = st;
    if (threadIdx.x == 0) (void)xb_add(&bar[XB_XCNT(b.x)], 1u);
    return b;
}
DEV void xcd_barrier_complete(unsigned* bar, unsigned x, unsigned& nloc, unsigned& nx) {
    const unsigned G = gridDim.x * gridDim.y * gridDim.z;
    unsigned sum, cnt, mine, sp = 0u;
    for (;;) {
        sum = 0u; cnt = 0u; mine = 0u;
#pragma unroll
        for (unsigned j = 0; j < 16; ++j) { const unsigned c = xb_ld(&bar[XB_XCNT(j)]); sum += c; cnt += (c > 0u) ? 1u : 0u; mine = (j == x) ? c : mine; }
        if (sum == G) break;
        __builtin_amdgcn_s_sleep(1);
        if ((++sp & 255u) == 0u) { if (xb_ld(&bar[XB_TMO])) break; if (sp > XB_SPIN_CAP) { atomicAdd(&bar[XB_TMO], 1u); break; } }
    }
    nloc = mine > 0u ? mine : 1u; nx = cnt > 0u ? cnt : 1u;
}
DEV void xcd_barrier(const XcdBarrier& b) {
    asm volatile("s_waitcnt vmcnt(0)" ::: "memory");
    __syncthreads();
    if (threadIdx.x == 0) {
        unsigned* bar = b.bar;
        __builtin_amdgcn_s_waitcnt(0);
        unsigned nloc = b.st[0], nx = b.st[1];
        if (nloc == 0u) { xcd_barrier_complete(bar, b.x, nloc, nx); b.st[0] = nloc; b.st[1] = nx; }
        const unsigned old = xb_add(&bar[XB_XSUB(b.x)], 1u);
        const unsigned gen = old / nloc;
        if (old + 1u == (gen + 1u) * nloc) {
            __builtin_amdgcn_fence(__ATOMIC_RELEASE, "agent");
            asm volatile("s_waitcnt vmcnt(0)" ::: "memory");
            const unsigned og = xb_add(&bar[XB_TOP], 1u);
            const unsigned tg = og / nx;
            if (og + 1u == (tg + 1u) * nx) xb_add(&bar[XB_TOPGEN], 1u);
            else XB_SPIN(xb_ld(&bar[XB_TOPGEN]) == tg, bar);
            __builtin_amdgcn_fence(__ATOMIC_ACQUIRE, "agent");
            xb_add(&bar[XB_XGEN(b.x)], 1u);
            asm volatile("s_waitcnt vmcnt(0)" ::: "memory");
        } else {
            XB_SPIN(xb_ld(&bar[XB_XGEN(b.x)]) == gen, bar);
            __builtin_amdgcn_fence(__ATOMIC_ACQUIRE, "agent");
            asm volatile("s_waitcnt vmcnt(0)" ::: "memory");
        }
    }
    __syncthreads();
}

constexpr int NPHASE = 21;
__host__ __device__ inline int phase_items(int ph) {
    if (ph == 0) return NCONV + NMOD + 1 + NCACHE;
    const int l = (ph - 1) / 10, k = (ph - 1) % 10;
    switch (k) {
        case 0: return 384 + (l == 1 ? (NCONV - NCONV_EARLY) + NCACHE : 0);
        case 1: return 96 * 31;
        case 2: return 512 + 512 + 512 + 768;
        case 3: return 512 + 512;
        case 4: return 768 + 768;
        case 5: return 96 * 16;
        case 6: return 96 * 16;
        case 7: return 384;
        case 8: return 96 * 44;
        default: return 96 * 16;
    }
}

DEV void run_phase(const Params& p, int ph, char* lds, int rep = 0) {
    const int nitems = phase_items(ph);
    char* ws = p.ws;
    if (ph == 0) {
        for (int it = blockIdx.x; it < nitems; it += gridDim.x) {
            int tid = threadIdx.x;
            asm volatile("" : "+v"(tid));
            if (it < NCONV) conv_item(p, 0, it, lds, tid);
            else if (it < NCONV + NMOD) mod_item(p, it - NCONV, lds, tid);
            else if (it == NCONV + NMOD) rope_item(p, tid);
            else cache_item(p, 0, it - (NCONV + NMOD + 1), tid);
        }
        return;
    }
    const int l = (ph - 1) / 10, k = (ph - 1) % 10;
    if (k == 2) { p2_phase(p, l, lds); return; }
    if (k == 5) { p5_phase(p, l, lds); return; }
    if (k == 8) { p8_phase(p, l, lds); return; }
    for (int it = blockIdx.x; it < nitems; it += gridDim.x) {
        int tid = threadIdx.x;
        asm volatile("" : "+v"(tid));
        switch (k) {
            case 0:
                if (it < 384) norm_item<8>(p, l, 0, it, tid);
                else if (it < 384 + (NCONV - NCONV_EARLY)) conv_item(p, 1, NCONV_EARLY + (it - 384), lds, tid);
                else cache_item(p, 1, it - 384 - (NCONV - NCONV_EARLY), tid);
                break;
            case 1: p1_tile(p, l, it, lds, tid); break;
            case 2: {
                if (rep && ((it >= 512 && it < 1024) || (it >= 1024 && it < 1536 && ((it >> 4) & 1)))) break;
                if (it < 512) {
                    const int j = it & 7, r = it >> 3, b = j >> 2, hm = (j & 3) * 2 + (r >> 5), qb = r & 31, bs = 16 + b;
                    attn_item<128>((const u16*)(ws + OFF_QD), hm * 64, 4096 + b * 4096 + qb * 128, kd_ptr(ws, bs, hm), vdt_ptr(ws, bs, hm >> 1), 4608, (u16*)(ws + OFF_DIFFO), 1024, hm * 128, lds, tid);
                } else if (it < 1024) {
                    const int i2 = it - 512, j = i2 & 7, r = i2 >> 3, b = j >> 2, kvh = (j >> 1) & 1, hh = kvh * 4 + (j & 1) * 2 + (r >> 5), qb = r & 31, bs = 16 + b;
                    attn_item<64>((const u16*)(ws + OFF_QG), hh * 64, 4096 + b * 4096 + qb * 128, kg_ptr(ws, bs, hh >> 2), vgt_ptr(ws, bs, hh >> 2), 4608, (u16*)(ws + OFF_QG), 512, hh * 64, lds, tid);
                } else if (it < 1536) {
                    const int i2 = it - 1024, bs = i2 >> 5, ty = (i2 >> 4) & 1, hh = (i2 >> 1) & 7, qb = i2 & 1;
                    if (ty == 0) attn_item<128>((const u16*)(ws + OFF_QD), hh * 64, bs * 256 + qb * 128, kd_ptr(ws, bs, hh), vdt_ptr(ws, bs, hh >> 1), 256, (u16*)(ws + OFF_DIFFO), 1024, hh * 128, lds, tid);
                    else attn_item<64>((const u16*)(ws + OFF_QG), hh * 64, bs * 256 + qb * 128, kg_ptr(ws, bs, hh >> 2), vgt_ptr(ws, bs, hh >> 2), 256, (u16*)(ws + OFF_QG), 512, hh * 64, lds, tid);
                } else gla1_item(p, l, it - 1536, lds, tid);
                break;
            }
            case 3: scan_item(p, l, it, tid); break;
            case 4:
                if (it < 768) gla3_item(p, l, it, tid);
                else { const int j = it - 768, di = j < 256 ? j : (j >= 512 ? j - 256 : -1); if (di >= 0) diffc_item(p, l, di, tid); }
                break;
            case 5: p5_tile(p, l, it, lds, tid); break;
            case 6: resid_tile(p, l, 0, it, lds, tid, -1); break;
            case 7: norm_item<8>(p, l, 1, it, tid); break;
            case 8: p8_tile(p, l, it, lds, tid); break;
            default: resid_tile(p, l, 1, it, lds, tid, -1); break;
        }
    }
}

__global__ void __launch_bounds__(256, 2) fwd_kernel(Params p) {
    __shared__ __attribute__((aligned(16))) char lds[73728 + 16];
#ifdef ONE_LAUNCH
    volatile LAS unsigned* st = (volatile LAS unsigned*)(lds + 73728);
    if (threadIdx.x == 0) { st[0] = 0u; st[1] = 0u; }
    __syncthreads();
    XcdBarrier xb = xcd_barrier_post((unsigned*)(p.ws + OFF_BAR), st);
    if (p.pad0 == 0x7fffffff) cg::this_grid().sync();
#endif
    for (int ph = p.phase_lo; ph <= p.phase_hi; ++ph) {
        if (phase_items(ph) == 0) continue;
#ifdef PROBE_REP
        if (ph > 0 && ((PROBE_REP >> ((ph - 1) % 10)) & 1)) { run_phase(p, ph, lds, 1); xcd_barrier(xb); }
#endif
        run_phase(p, ph, lds);
#ifdef ONE_LAUNCH
        if (ph < p.phase_hi) xcd_barrier(xb);
#endif
    }
}

extern "C" void kernel_launch(void* const* d_in, const int* in_sizes, int n_in, void* d_out, int out_size, void* d_ws, size_t ws_size, hipStream_t stream) {
    Params p{};
    const float** f = (const float**)&p;
    for (int i = 0; i < 27; ++i) f[i] = (const float*)d_in[i];
    p.out = (float*)d_out;
    p.ws = (char*)d_ws;
    if (ws_size < WS_END) { fprintf(stderr, "workspace too small: %zu < %zu\n", ws_size, (size_t)WS_END); return; }
#ifndef ONE_LAUNCH
    for (int ph = 0; ph < NPHASE; ++ph) {
        Params q = p;
        q.phase_lo = ph; q.phase_hi = ph;
        int g = phase_items(ph);
        if (g > 2048) g = 2048;
        hipLaunchKernelGGL(fwd_kernel, dim3(g), dim3(256), 0, stream, q);
    }
#else
    static int grid_blocks = 0;
    if (!grid_blocks) {
        int dev = 0, cus = 0, per_cu = 0;
        hipGetDevice(&dev);
        hipDeviceGetAttribute(&cus, hipDeviceAttributeMultiprocessorCount, dev);
        hipOccupancyMaxActiveBlocksPerMultiprocessor(&per_cu, fwd_kernel, 256, 0);
        if (per_cu > 2) per_cu = 2;
        grid_blocks = cus * per_cu;
    }
    p.phase_lo = 0; p.phase_hi = NPHASE - 1;
    hipMemsetAsync((char*)d_ws + OFF_BAR, 0, (size_t)(OFF_CNT - OFF_BAR) + (size_t)3 * 128 * 4, stream);
    void* args[] = {&p};
    hipError_t e = hipLaunchCooperativeKernel((void*)fwd_kernel, dim3(grid_blocks), dim3(256), args, 0, stream);
    if (e != hipSuccess) fprintf(stderr, "cooperative launch failed: %s (grid %d)\n", hipGetErrorString(e), grid_blocks);
#endif
}
```

```cpp
#define ONE_LAUNCH 1
#include <hip/hip_runtime.h>
#include <hip/hip_cooperative_groups.h>
#include <cstdio>
#include <cstdint>
namespace cg = cooperative_groups;

#define DEV __device__ __forceinline__
typedef unsigned short u16;
typedef short bf16x8 __attribute__((ext_vector_type(8)));
typedef float f32x4 __attribute__((ext_vector_type(4)));
typedef unsigned u32x4 __attribute__((ext_vector_type(4)));
typedef unsigned u32x2 __attribute__((ext_vector_type(2)));
#define LAS __attribute__((address_space(3)))

constexpr int NTOK = 12288;
constexpr int DM = 1024;
constexpr int NIN_SRC = 6944;
constexpr int NWIN = 7040;
constexpr int FFH = 2816;
constexpr float EPSV = 1e-6f;
constexpr float QSCALE = 0.125f * 1.4426950408889634f;

constexpr size_t al256(size_t x) { return (x + 255) & ~(size_t)255; }
constexpr size_t OFF_WIN = 0;
constexpr size_t OFF_WBR = OFF_WIN + al256((size_t)NWIN * 1024 * 2);
constexpr size_t OFF_WOUT = OFF_WBR + al256((size_t)3 * 1024 * 512 * 2);
constexpr size_t OFF_WFI = OFF_WOUT + al256((size_t)1024 * 1024 * 2);
constexpr size_t OFF_WFO = OFF_WFI + al256((size_t)5632 * 1024 * 2);
constexpr size_t OFF_MOD = OFF_WFO + al256((size_t)1024 * 2816 * 2);
constexpr size_t OFF_ROPE = OFF_MOD + al256((size_t)2 * 3 * 6144 * 4);
constexpr size_t OFF_H = OFF_ROPE + al256((size_t)64 * 16 * 2 * 4);
constexpr size_t OFF_QG = OFF_H + al256((size_t)NTOK * 1024 * 2);
constexpr size_t OFF_QD = OFF_QG + al256((size_t)NTOK * 512 * 2);
constexpr size_t OFF_KGC = OFF_QD + al256((size_t)NTOK * 512 * 2);
constexpr size_t OFF_VGC = OFF_KGC + al256((size_t)16 * 2 * 256 * 64 * 2);
constexpr size_t OFF_KDC = OFF_VGC + al256((size_t)16 * 2 * 256 * 64 * 2);
constexpr size_t OFF_VDC = OFF_KDC + al256((size_t)16 * 8 * 256 * 64 * 2);
constexpr size_t OFF_KGL = OFF_VDC + al256((size_t)16 * 4 * 128 * 256 * 2);
constexpr size_t OFF_VGL = OFF_KGL + al256((size_t)2 * 2 * 4608 * 64 * 2);
constexpr size_t OFF_KDL = OFF_VGL + al256((size_t)2 * 2 * 4608 * 64 * 2);
constexpr size_t OFF_VDL = OFF_KDL + al256((size_t)2 * 8 * 4608 * 64 * 2);
constexpr size_t OFF_LQ = OFF_VDL + al256((size_t)2 * 4 * 128 * 4608 * 2);
constexpr size_t OFF_LK = OFF_LQ + al256((size_t)NTOK * 256 * 2);
constexpr size_t OFF_LVT = OFF_LK + al256((size_t)NTOK * 256 * 2);
constexpr size_t OFF_LGO = OFF_LVT + al256((size_t)NTOK * 512 * 2);
constexpr size_t OFF_LR = OFF_LGO + al256((size_t)NTOK * 512 * 2);
constexpr size_t OFF_DIFFO = OFF_LR + al256((size_t)NTOK * 32 * 4);
constexpr size_t OFF_QDG = OFF_DIFFO + al256((size_t)NTOK * 1024 * 2);
constexpr size_t OFF_OI = OFF_QDG + al256((size_t)2 * NTOK * 256 * 2);
constexpr size_t OFF_DST = OFF_OI + al256((size_t)768 * 4 * 8 * 64 * 8);
constexpr size_t OFF_DECAY = OFF_DST + al256((size_t)1536 * 8192 * 2);
constexpr size_t OFF_BAR = OFF_DECAY + al256((size_t)1536 * 64 * 4);
constexpr size_t OFF_CNT = OFF_BAR + al256((size_t)3456 * 4);
constexpr size_t OFF_XB = OFF_CNT + al256((size_t)3 * 128 * 4);
constexpr size_t WS_END = OFF_XB + al256((size_t)NTOK * 1024 * 2);
constexpr size_t OFF_SPREV = OFF_KGC;
constexpr size_t OFF_MIXED = OFF_KGC;
constexpr size_t OFF_GLAOUT = OFF_LQ;
constexpr size_t OFF_DIFFOUT = OFF_LVT;
constexpr size_t OFF_ACT = OFF_DIFFO;
static_assert(OFF_LQ - OFF_KGC >= (size_t)NTOK * 1024 * 2, "alias");
static_assert(OFF_DECAY - OFF_DIFFO >= (size_t)NTOK * 2816 * 2, "alias");
static_assert(WS_END <= (size_t)256 * 1024 * 1024, "ws");

constexpr size_t OUT_GK = 12582912, OUT_GV = 13631488, OUT_ST = 14680064, OUT_DK = 16777216, OUT_DV = 20971520;

struct Params {
    const float *x_prompt, *x_sample, *c, *cache_gqa_k, *cache_gqa_v, *state_gla, *cache_diff_k, *cache_diff_v, *c_ctx,
        *w_mod, *b_mod, *norm1, *norm2, *w_in, *gqa_q_norm, *gqa_k_norm, *gla_alpha_up, *gla_alpha_bias, *gla_out_norm,
        *diff_q_norm, *diff_k_norm, *diff_lambda, *diff_sub_norm, *w_branch, *w_out, *w_ffn_in, *w_ffn_out;
    float* out;
    char* ws;
    int phase_lo, phase_hi, pad0, pad1;
};

typedef __bf16 bf16x2_t __attribute__((ext_vector_type(2)));
typedef float f32x2_t __attribute__((ext_vector_type(2)));
DEV u16 f2bf(float f) { const __bf16 b = (__bf16)f; return __builtin_bit_cast(u16, b); }
DEV float bf2f(u16 h) { return __uint_as_float(((unsigned)h) << 16); }
DEV unsigned pack2(float lo, float hi) { const f32x2_t v = {lo, hi}; const bf16x2_t b = __builtin_convertvector(v, bf16x2_t); return __builtin_bit_cast(unsigned, b); }
DEV float sigmoidf_(float x) { return 1.0f / (1.0f + __expf(-x)); }
DEV float siluf_(float x) { return x / (1.0f + __expf(-x)); }
DEV int tok_cond(int t) { return t < 4096 ? 0 : 1 + ((t - 4096) >> 12); }
DEV int tok_bs(int t) { return t < 4096 ? (t >> 8) : 16 + ((t - 4096) >> 12); }
DEV int tok_n(int t) { return t < 4096 ? (t & 255) : ((t - 4096) & 4095); }
DEV f32x4 mfma16(bf16x8 a, bf16x8 b, f32x4 c) { return __builtin_amdgcn_mfma_f32_16x16x32_bf16(a, b, c, 0, 0, 0); }

DEV u16* kg_ptr(char* ws, int bs, int kv) { return bs < 16 ? (u16*)(ws + OFF_KGC) + (size_t)((bs * 2 + kv) * 256) * 64 : (u16*)(ws + OFF_KGL) + (size_t)(((bs - 16) * 2 + kv) * 4608) * 64; }
DEV u16* vgt_ptr(char* ws, int bs, int kv) { return bs < 16 ? (u16*)(ws + OFF_VGC) + (size_t)((bs * 2 + kv) * 64) * 256 : (u16*)(ws + OFF_VGL) + (size_t)(((bs - 16) * 2 + kv) * 64) * 4608; }
DEV u16* kd_ptr(char* ws, int bs, int hm) { return bs < 16 ? (u16*)(ws + OFF_KDC) + (size_t)((bs * 8 + hm) * 256) * 64 : (u16*)(ws + OFF_KDL) + (size_t)(((bs - 16) * 8 + hm) * 4608) * 64; }
DEV u16* vdt_ptr(char* ws, int bs, int h) { return bs < 16 ? (u16*)(ws + OFF_VDC) + (size_t)((bs * 4 + h) * 128) * 256 : (u16*)(ws + OFF_VDL) + (size_t)(((bs - 16) * 4 + h) * 128) * 4608; }
DEV u16* lvt_ptr(char* ws, int bs, int h) { return bs < 16 ? (u16*)(ws + OFF_LVT) + (size_t)((bs * 4 + h) * 128) * 256 : (u16*)(ws + OFF_LVT) + (size_t)2097152 + (size_t)(((bs - 16) * 4 + h) * 128) * 4096; }

template <int ROWS, int SW = 0>
DEV void stage_rows(const u16* g, unsigned ld, char* lds, int tid) {
    const int wbase = __builtin_amdgcn_readfirstlane(tid >> 6) * 64;
    const char* gb = (const char*)g;
#pragma unroll
    for (int i = 0; i < ROWS / 32; ++i) {
        const int idx = tid + i * 256;
        const int r = idx >> 3, s = idx & 7;
        const int c = s ^ (SW == 0 ? (r & 7) : ((r >> 1) & 7));
        const unsigned off = ((unsigned)r * ld + (unsigned)c * 8u) * 2u;
        __builtin_amdgcn_global_load_lds((const void*)(gb + off), (LAS void*)(lds + (wbase + i * 256) * 16), 16, 0, 0);
    }
}
DEV bf16x8 lds_frag(const char* tile, int row, int chunk) { return *(const bf16x8*)(tile + row * 128 + ((chunk ^ (row & 7)) << 4)); }
DEV bf16x8 lds_frag1(const char* tile, int row, int chunk) { return *(const bf16x8*)(tile + row * 128 + ((chunk ^ ((row >> 1) & 7)) << 4)); }
typedef float f32x16 __attribute__((ext_vector_type(16)));
DEV f32x16 mfma32(bf16x8 a, bf16x8 b, f32x16 c) { return __builtin_amdgcn_mfma_f32_32x32x16_bf16(a, b, c, 0, 0, 0); }
DEV void wait_vm0() { asm volatile("s_waitcnt vmcnt(0)" ::: "memory"); }

template <int NT, bool TR = false>
DEV void gemm_mainloop(f32x4 (&acc)[4][NT], const u16* A, unsigned lda, const u16* B, unsigned ldb, int K, char* lds, int tid) {
    constexpr int BN = NT * 32;
    constexpr int AB = 128 * 128, BB = BN * 128, STG = AB + BB;
    const int lane = tid & 63, wid = __builtin_amdgcn_readfirstlane(tid >> 6), wr = wid >> 1, wc = wid & 1, fr = lane & 15, fq = lane >> 4;
    const int nk = K >> 6;
    stage_rows<128>(A, lda, lds, tid);
    stage_rows<BN>(B, ldb, lds + AB, tid);
    for (int kt = 0; kt < nk; ++kt) {
        char* cur = lds + (kt & 1) * STG;
        wait_vm0();
        __syncthreads();
        if (kt + 1 < nk) {
            char* nxt = lds + ((kt + 1) & 1) * STG;
            stage_rows<128>(A + (size_t)(kt + 1) * 64, lda, nxt, tid);
            stage_rows<BN>(B + (size_t)(kt + 1) * 64, ldb, nxt + AB, tid);
        }
        {
            bf16x8 a[2][4], b[2][NT];
#pragma unroll
            for (int ks = 0; ks < 2; ++ks) {
#pragma unroll
                for (int m = 0; m < 4; ++m) a[ks][m] = lds_frag(cur, wr * 64 + m * 16 + fr, ks * 4 + fq);
#pragma unroll
                for (int n = 0; n < NT; ++n) b[ks][n] = lds_frag(cur + AB, wc * (NT * 16) + n * 16 + fr, ks * 4 + fq);
            }
            __builtin_amdgcn_sched_barrier(0);
#pragma unroll
            for (int ks = 0; ks < 2; ++ks)
#pragma unroll
                for (int m = 0; m < 4; ++m)
#pragma unroll
                    for (int n = 0; n < NT; ++n) acc[m][n] = TR ? mfma16(b[ks][n], a[ks][m], acc[m][n]) : mfma16(a[ks][m], b[ks][n], acc[m][n]);
        }
    }
    __syncthreads();
}

template <int NT>
DEV void zero_acc(f32x4 (&acc)[4][NT]) {
#pragma unroll
    for (int m = 0; m < 4; ++m)
#pragma unroll
        for (int n = 0; n < NT; ++n) acc[m][n] = (f32x4){0.f, 0.f, 0.f, 0.f};
}

template <int NT, bool TR>
DEV void gemm_chain(f32x4 (&acc)[4][NT], const u16* A, unsigned lda, const u16* B, unsigned ldb, int K,
                    bool has_next, const u16* nA, unsigned nlda, const u16* nB, unsigned nldb, int& par, bool& pre, char* lds, int tid) {
    constexpr int BN = NT * 32;
    constexpr int AB = 128 * 128, BB = BN * 128, STG = AB + BB;
    const int lane = tid & 63, wid = __builtin_amdgcn_readfirstlane(tid >> 6), wr = wid >> 1, wc = wid & 1, fr = lane & 15, fq = lane >> 4;
    const int nk = K >> 6;
    if (!pre) {
        stage_rows<128>(A, lda, lds + par * STG, tid);
        stage_rows<BN>(B, ldb, lds + par * STG + AB, tid);
    }
    for (int kt = 0; kt < nk; ++kt) {
        char* cur = lds + ((par + kt) & 1) * STG;
        char* nxt = lds + ((par + kt + 1) & 1) * STG;
        wait_vm0();
        __syncthreads();
        if (kt + 1 < nk) {
            stage_rows<128>(A + (size_t)(kt + 1) * 64, lda, nxt, tid);
            stage_rows<BN>(B + (size_t)(kt + 1) * 64, ldb, nxt + AB, tid);
        } else if (has_next) {
            stage_rows<128>(nA, nlda, nxt, tid);
            stage_rows<BN>(nB, nldb, nxt + AB, tid);
        }
        {
            bf16x8 a[2][4], b[2][NT];
#pragma unroll
            for (int ks = 0; ks < 2; ++ks) {
#pragma unroll
                for (int m = 0; m < 4; ++m) a[ks][m] = lds_frag(cur, wr * 64 + m * 16 + fr, ks * 4 + fq);
#pragma unroll
                for (int n = 0; n < NT; ++n) b[ks][n] = lds_frag(cur + AB, wc * (NT * 16) + n * 16 + fr, ks * 4 + fq);
            }
            __builtin_amdgcn_sched_barrier(0);
#pragma unroll
            for (int ks = 0; ks < 2; ++ks)
#pragma unroll
                for (int m = 0; m < 4; ++m)
#pragma unroll
                    for (int n = 0; n < NT; ++n) acc[m][n] = TR ? mfma16(b[ks][n], a[ks][m], acc[m][n]) : mfma16(a[ks][m], b[ks][n], acc[m][n]);
        }
    }
    par = (par + nk) & 1;
    pre = has_next;
    if (!has_next) __syncthreads();
}

template <int NT, bool TR>
DEV void gemm_chain2(f32x4 (&acc)[4][NT], const u16* A, unsigned lda, const u16* B, unsigned ldb, int K,
                     bool has_next, const u16* nA, unsigned nlda, const u16* nB, unsigned nldb, int& par, int& pre, char* lds, int tid) {
    constexpr int BN = NT * 32;
    constexpr int AB = 128 * 128, BB = BN * 128, STG = AB + BB;
    static_assert(NT == 2 || NT == 4, "vmcnt literals");
    const int lane = tid & 63, wid = __builtin_amdgcn_readfirstlane(tid >> 6), wr = wid >> 1, wc = wid & 1, fr = lane & 15, fq = lane >> 4;
    const int nk = K >> 6;
    if (pre < 1) { stage_rows<128>(A, lda, lds + par * STG, tid); stage_rows<BN>(B, ldb, lds + par * STG + AB, tid); }
    if (pre < 2) { stage_rows<128>(A + 64, lda, lds + (par ^ 1) * STG, tid); stage_rows<BN>(B + 64, ldb, lds + (par ^ 1) * STG + AB, tid); }
    for (int kt = 0; kt < nk; ++kt) {
        char* cur = lds + ((par + kt) & 1) * STG;
        const bool younger = (kt + 1 < nk) || has_next;
        if (kt == 0 || !younger) asm volatile("s_waitcnt vmcnt(0)" ::: "memory");
        else if (NT == 4) asm volatile("s_waitcnt vmcnt(8)" ::: "memory");
        else asm volatile("s_waitcnt vmcnt(6)" ::: "memory");
        __builtin_amdgcn_s_barrier();
        asm volatile("" ::: "memory");
        bf16x8 a[2][4], b[2][NT];
#pragma unroll
        for (int ks = 0; ks < 2; ++ks) {
#pragma unroll
            for (int m = 0; m < 4; ++m) a[ks][m] = lds_frag(cur, wr * 64 + m * 16 + fr, ks * 4 + fq);
#pragma unroll
            for (int n = 0; n < NT; ++n) b[ks][n] = lds_frag(cur + AB, wc * (NT * 16) + n * 16 + fr, ks * 4 + fq);
        }
        asm volatile("s_waitcnt lgkmcnt(0)" ::: "memory");
        __builtin_amdgcn_s_barrier();
        asm volatile("" ::: "memory");
        if (kt + 2 < nk) {
            stage_rows<128>(A + (size_t)(kt + 2) * 64, lda, cur, tid);
            stage_rows<BN>(B + (size_t)(kt + 2) * 64, ldb, cur + AB, tid);
        } else if (has_next) {
            const int j = kt + 2 - nk;
            stage_rows<128>(nA + (size_t)j * 64, nlda, cur, tid);
            stage_rows<BN>(nB + (size_t)j * 64, nldb, cur + AB, tid);
        }
        __builtin_amdgcn_sched_barrier(0);
#pragma unroll
        for (int ks = 0; ks < 2; ++ks)
#pragma unroll
            for (int m = 0; m < 4; ++m)
#pragma unroll
                for (int n = 0; n < NT; ++n) acc[m][n] = TR ? mfma16(b[ks][n], a[ks][m], acc[m][n]) : mfma16(a[ks][m], b[ks][n], acc[m][n]);
    }
    par = (par + nk) & 1;
    pre = has_next ? 2 : 0;
    if (!has_next) __syncthreads();
}

template <int NT, bool TR = false>
DEV void gemm_mainloop3(f32x4 (&acc)[4][NT], const u16* A, unsigned lda, const u16* B, unsigned ldb, int K, char* lds, int tid) {
    constexpr int BN = NT * 32;
    constexpr int AB = 128 * 128, BB = BN * 128, STG = AB + BB;
    static_assert(NT == 2, "vmcnt literal below assumes 6 DMA pieces per thread per tile");
    const int lane = tid & 63, wid = __builtin_amdgcn_readfirstlane(tid >> 6), wr = wid >> 1, wc = wid & 1, fr = lane & 15, fq = lane >> 4;
    const int nk = K >> 6;
    wait_vm0();
    stage_rows<128>(A, lda, lds, tid);
    stage_rows<BN>(B, ldb, lds + AB, tid);
    stage_rows<128>(A + 64, lda, lds + STG, tid);
    stage_rows<BN>(B + 64, ldb, lds + STG + AB, tid);
    int cb = 0;
    for (int kt = 0; kt < nk; ++kt) {
        char* cur = lds + cb * STG;
        if (kt + 1 < nk) asm volatile("s_waitcnt vmcnt(6)" ::: "memory");
        else asm volatile("s_waitcnt vmcnt(0)" ::: "memory");
        asm volatile("s_waitcnt lgkmcnt(0)" ::: "memory");
        __builtin_amdgcn_s_barrier();
        asm volatile("" ::: "memory");
        if (kt + 2 < nk) {
            const int nb = cb == 0 ? 2 : cb - 1;
            char* nxt = lds + nb * STG;
            stage_rows<128>(A + (size_t)(kt + 2) * 64, lda, nxt, tid);
            stage_rows<BN>(B + (size_t)(kt + 2) * 64, ldb, nxt + AB, tid);
        }
        {
            bf16x8 a[2][4], b[2][NT];
#pragma unroll
            for (int ks = 0; ks < 2; ++ks) {
#pragma unroll
                for (int m = 0; m < 4; ++m) a[ks][m] = lds_frag(cur, wr * 64 + m * 16 + fr, ks * 4 + fq);
#pragma unroll
                for (int n = 0; n < NT; ++n) b[ks][n] = lds_frag(cur + AB, wc * (NT * 16) + n * 16 + fr, ks * 4 + fq);
            }
            __builtin_amdgcn_sched_barrier(0);
#pragma unroll
            for (int ks = 0; ks < 2; ++ks)
#pragma unroll
                for (int m = 0; m < 4; ++m)
#pragma unroll
                    for (int n = 0; n < NT; ++n) acc[m][n] = TR ? mfma16(b[ks][n], a[ks][m], acc[m][n]) : mfma16(a[ks][m], b[ks][n], acc[m][n]);
        }
        cb = cb == 2 ? 0 : cb + 1;
    }
    __syncthreads();
}

DEV int win_map(int c) { return c < 1792 ? c : (c < 3840 ? c + 32 : (c < 3872 ? c - 2048 : (c < 3968 ? -1 : c - 96))); }
DEV int wfi_map(int c) { const int tn = c >> 7, wc = (c >> 6) & 1, nt = (c >> 4) & 3, fr = c & 15; return (nt >> 1) * 2816 + tn * 64 + wc * 32 + (nt & 1) * 16 + fr; }

DEV void conv_tile(const float* src, size_t ld, int K, int kind, int n0, int k0, u16* dst, char* lds, int tid) {
    float* tile = (float*)lds;
    const int c = tid & 63;
    const int nn = n0 + c;
    const int sc = kind == 0 ? win_map(nn) : (kind == 3 ? wfi_map(nn) : nn);
    const int kb = tid >> 6;
    float v[32];
#pragma unroll
    for (int i = 0; i < 32; ++i) v[i] = sc >= 0 ? src[(size_t)(k0 + i * 4 + kb) * ld + sc] : 0.f;
#pragma unroll
    for (int i = 0; i < 32; ++i) tile[(i * 4 + kb) * 65 + c] = v[i];
    __syncthreads();
    const int nrow = tid >> 2, kq = tid & 3;
    unsigned w[16];
#pragma unroll
    for (int i = 0; i < 16; ++i) w[i] = pack2(tile[(kq * 32 + 2 * i) * 65 + nrow], tile[(kq * 32 + 2 * i + 1) * 65 + nrow]);
    u16* d = dst + (size_t)(n0 + nrow) * K + k0 + kq * 32;
#pragma unroll
    for (int i = 0; i < 4; ++i) *(u32x4*)(d + i * 8) = (u32x4){w[4 * i], w[4 * i + 1], w[4 * i + 2], w[4 * i + 3]};
    __syncthreads();
}

constexpr int NCONV = 880 + 192 + 128 + 704 + 352;
constexpr int NCONV_EARLY = 880 + 192 + 128;
DEV void conv_item(const Params& p, int l, int it, char* lds, int tid) {
    char* ws = p.ws;
    if (it < 880) { conv_tile(p.w_in + (size_t)l * 1024 * NIN_SRC, NIN_SRC, 1024, 0, (it >> 3) * 64, (it & 7) * 128, (u16*)(ws + OFF_WIN), lds, tid); return; }
    it -= 880;
    if (it < 192) { const int i = it / 64, r = it % 64; conv_tile(p.w_branch + (size_t)(l * 3 + i) * 512 * 1024, 1024, 512, 1, (r >> 2) * 64, (r & 3) * 128, (u16*)(ws + OFF_WBR) + (size_t)i * 1024 * 512, lds, tid); return; }
    it -= 192;
    if (it < 128) { conv_tile(p.w_out + (size_t)l * 1024 * 1024, 1024, 1024, 2, (it >> 3) * 64, (it & 7) * 128, (u16*)(ws + OFF_WOUT), lds, tid); return; }
    it -= 128;
    if (it < 704) { conv_tile(p.w_ffn_in + (size_t)l * 1024 * 5632, 5632, 1024, 3, (it >> 3) * 64, (it & 7) * 128, (u16*)(ws + OFF_WFI), lds, tid); return; }
    it -= 704;
    { conv_tile(p.w_ffn_out + (size_t)l * 2816 * 1024, 1024, 2816, 4, (it / 22) * 64, (it % 22) * 128, (u16*)(ws + OFF_WFO), lds, tid); }
}

constexpr int NMOD = 384;
DEV void mod_item(const Params& p, int it, char* lds, int tid) {
    const int l = it / 192, cb = it % 192;
    float* sc = (float*)lds;
    float* red = (float*)(lds + 12288);
    for (int i = tid; i < 3072; i += 256) {
        const int cnd = i >> 10, k = i & 1023;
        const float v = cnd == 0 ? p.c_ctx[k] : p.c[(cnd - 1) * 1024 + k];
        sc[i] = siluf_(v);
    }
    __syncthreads();
    const int cgp = tid & 7, kg = tid >> 3;
    float acc[3][4];
#pragma unroll
    for (int a = 0; a < 3; ++a)
#pragma unroll
        for (int b = 0; b < 4; ++b) acc[a][b] = 0.f;
    const float* wbase = p.w_mod + (size_t)l * 1024 * 6144 + cb * 32 + cgp * 4;
#pragma unroll 16
    for (int kk = 0; kk < 32; ++kk) {
        const int k = kg * 32 + kk;
        const float4 w = *(const float4*)(wbase + (size_t)k * 6144);
#pragma unroll
        for (int a = 0; a < 3; ++a) { const float sv = sc[a * 1024 + k]; acc[a][0] += sv * w.x; acc[a][1] += sv * w.y; acc[a][2] += sv * w.z; acc[a][3] += sv * w.w; }
    }
#pragma unroll
    for (int a = 0; a < 3; ++a)
#pragma unroll
        for (int b = 0; b < 4; ++b) red[(kg * 3 + a) * 32 + cgp * 4 + b] = acc[a][b];
    __syncthreads();
    if (tid < 96) {
        const int a = tid >> 5, col = tid & 31;
        float sum = p.b_mod[l * 6144 + cb * 32 + col];
#pragma unroll
        for (int g = 0; g < 32; ++g) sum += red[(g * 3 + a) * 32 + col];
        ((float*)(p.ws + OFF_MOD))[(l * 3 + a) * 6144 + cb * 32 + col] = sum;
    }
    __syncthreads();
}

DEV void rope_item(const Params& p, int tid) {
    float* tab = (float*)(p.ws + OFF_ROPE);
    for (int i = tid; i < 1024; i += 256) {
        const int pos = i >> 4, f = i & 15;
        const float freq = powf(10000.0f, -(float)f / 16.0f);
        const float ang = (float)pos * freq;
        tab[i * 2] = cosf(ang);
        tab[i * 2 + 1] = sinf(ang);
    }
}

constexpr int NCACHE = 1280;
DEV void cache_item(const Params& p, int l, int it, int tid) {
    char* ws = p.ws;
    float v[4];
    size_t doff[4];
    u16* dbase[4];
#pragma unroll
    for (int u = 0; u < 4; ++u) {
        const int idx = it * 1024 + u * 256 + tid;
        const int bp = idx / 1280, r = idx % 1280;
        const int b = bp >> 9, pp = bp & 511;
        const size_t srow = (size_t)((b * 2 + l) * 512 + pp);
        if (r < 128) { const int kv = r >> 6, d = r & 63; dbase[u] = (u16*)(ws + OFF_KGL); doff[u] = (size_t)((b * 2 + kv) * 4608 + 4096 + pp) * 64 + d; v[u] = p.cache_gqa_k[srow * 128 + r]; }
        else if (r < 256) { const int r2 = r - 128, kv = r2 >> 6, d = r2 & 63; dbase[u] = (u16*)(ws + OFF_VGL); doff[u] = (size_t)((b * 2 + kv) * 64 + d) * 4608 + 4096 + pp; v[u] = p.cache_gqa_v[srow * 128 + r2]; }
        else if (r < 768) { const int r2 = r - 256, hm = r2 >> 6, d = r2 & 63; dbase[u] = (u16*)(ws + OFF_KDL); doff[u] = (size_t)((b * 8 + hm) * 4608 + 4096 + pp) * 64 + d; v[u] = p.cache_diff_k[srow * 512 + r2]; }
        else { const int r2 = r - 768, h = r2 >> 7, e = r2 & 127; dbase[u] = (u16*)(ws + OFF_VDL); doff[u] = (size_t)((b * 4 + h) * 128 + e) * 4608 + 4096 + pp; v[u] = p.cache_diff_v[srow * 512 + r2]; }
    }
#pragma unroll
    for (int u = 0; u < 4; ++u) dbase[u][doff[u]] = f2bf(v[u]);
}

template <int RW = 4>
DEV void norm_item(const Params& p, int l, int which, int it, int tid) {
    const int lane = tid & 63, wid = __builtin_amdgcn_readfirstlane(tid >> 6);
    const int tb = it * (4 * RW) + wid * RW;
    const float* g = (which == 0 ? p.norm1 : p.norm2) + l * 1024;
    const float* mod = (const float*)(p.ws + OFF_MOD) + (size_t)(l * 3 + tok_cond(tb)) * 6144 + (which == 0 ? 0 : 3072);
    float4 v[RW][4];
#pragma unroll
    for (int r = 0; r < RW; ++r) {
        const int t = tb + r;
        if (which == 0 && l == 0) {
            const float* xr = t < 4096 ? p.x_prompt + (size_t)t * 1024 : p.x_sample + (size_t)(t - 4096) * 1024;
#pragma unroll
            for (int i = 0; i < 4; ++i) v[r][i] = *(const float4*)(xr + i * 256 + lane * 4);
        } else {
            const u16* xr = (const u16*)(p.ws + OFF_XB) + (size_t)t * 1024;
#pragma unroll
            for (int i = 0; i < 4; ++i) {
                const u32x2 w = *(const u32x2*)(xr + i * 256 + lane * 4);
                v[r][i] = make_float4(__uint_as_float(w.x << 16), __uint_as_float(w.x & 0xffff0000u), __uint_as_float(w.y << 16), __uint_as_float(w.y & 0xffff0000u));
            }
        }
    }
    float4 gg[4], sh[4], scv[4];
#pragma unroll
    for (int i = 0; i < 4; ++i) {
        const int e = i * 256 + lane * 4;
        gg[i] = *(const float4*)(g + e); sh[i] = *(const float4*)(mod + e); scv[i] = *(const float4*)(mod + 1024 + e);
        gg[i].x *= 1.f + scv[i].x; gg[i].y *= 1.f + scv[i].y; gg[i].z *= 1.f + scv[i].z; gg[i].w *= 1.f + scv[i].w;
    }
#pragma unroll
    for (int r = 0; r < RW; ++r) {
        float ss = 0.f;
#pragma unroll
        for (int i = 0; i < 4; ++i) ss += v[r][i].x * v[r][i].x + v[r][i].y * v[r][i].y + v[r][i].z * v[r][i].z + v[r][i].w * v[r][i].w;
#pragma unroll
        for (int o = 1; o < 64; o <<= 1) ss += __shfl_xor(ss, o);
        const float rstd = rsqrtf(ss * (1.0f / 1024.0f) + EPSV);
        u16* hr = (u16*)(p.ws + OFF_H) + (size_t)(tb + r) * 1024;
#pragma unroll
        for (int i = 0; i < 4; ++i) {
            const int e = i * 256 + lane * 4;
            const float a = v[r][i].x * rstd * gg[i].x + sh[i].x;
            const float b = v[r][i].y * rstd * gg[i].y + sh[i].y;
            const float c = v[r][i].z * rstd * gg[i].z + sh[i].z;
            const float d = v[r][i].w * rstd * gg[i].w + sh[i].w;
            *(u32x2*)(hr + e) = (u32x2){pack2(a, b), pack2(c, d)};
        }
    }
}

DEV void acc_to_rows(const f32x4 (&acc)[4][4], char* lds, int wid, int lane_in, float (&v)[64]) {
    int lane = lane_in;
    asm volatile("" : "+v"(lane));
    float* wt = (float*)(lds + wid * 16384);
    const int fr = lane & 15, fq = lane >> 4;
    int bj[4], bn[4];
#pragma unroll
    for (int j = 0; j < 4; ++j) bj[j] = fq * 256 + (fr ^ (4 * j)) + j * 64;
#pragma unroll
    for (int n = 0; n < 4; ++n) bn[n] = 16 * (n ^ fq);
#pragma unroll
    for (int m = 0; m < 4; ++m)
#pragma unroll
        for (int n = 0; n < 4; ++n)
#pragma unroll
            for (int j = 0; j < 4; ++j) wt[bj[j] + bn[n] + m * 1024] = acc[m][n][j];
    __syncthreads();
#pragma unroll
    for (int c4 = 0; c4 < 16; ++c4) {
        const float4 x = *(const float4*)(wt + lane * 64 + ((c4 ^ (lane & 15)) << 2));
        v[c4 * 4] = x.x; v[c4 * 4 + 1] = x.y; v[c4 * 4 + 2] = x.z; v[c4 * 4 + 3] = x.w;
    }
    __syncthreads();
}

DEV void row_norm_rope(float (&v)[64], const float* gain, bool rope, int n, const float* tab, float scale) {
    float ss = 0.f;
#pragma unroll
    for (int c = 0; c < 64; ++c) ss += v[c] * v[c];
    const float r = rsqrtf(ss * (1.0f / 64.0f) + EPSV);
#pragma unroll
    for (int c = 0; c < 64; ++c) v[c] = v[c] * r * gain[c];
    if (rope) {
        const int rp = n >> 6, cp = n & 63;
#pragma unroll
        for (int i = 0; i < 16; ++i) {
            const float2 a = *(const float2*)(tab + (rp * 16 + i) * 2);
            const float2 b = *(const float2*)(tab + (cp * 16 + i) * 2);
            const float x0 = v[i], x1 = v[16 + i], x2 = v[32 + i], x3 = v[48 + i];
            v[i] = x0 * a.x - x1 * a.y; v[16 + i] = x1 * a.x + x0 * a.y;
            v[32 + i] = x2 * b.x - x3 * b.y; v[48 + i] = x3 * b.x + x2 * b.y;
        }
    }
#pragma unroll
    for (int c = 0; c < 64; ++c) v[c] *= scale;
}
DEV void row_store_bf16(const float (&v)[64], u16* dst0, size_t ld, char* wl, int lane) {
#pragma unroll
    for (int i = 0; i < 8; ++i)
        *(u32x4*)(wl + lane * 128 + ((i ^ (lane & 7)) << 4)) = (u32x4){pack2(v[i * 8], v[i * 8 + 1]), pack2(v[i * 8 + 2], v[i * 8 + 3]), pack2(v[i * 8 + 4], v[i * 8 + 5]), pack2(v[i * 8 + 6], v[i * 8 + 7])};
    __builtin_amdgcn_wave_barrier();
    const int c = lane & 7;
#pragma unroll
    for (int i = 0; i < 8; ++i) {
        const int row = i * 8 + (lane >> 3);
        const u32x4 x = *(const u32x4*)(wl + row * 128 + ((c ^ (row & 7)) << 4));
        *(u32x4*)(dst0 + (size_t)row * ld + c * 8) = x;
    }
}
DEV void row_store_f32(const float (&v)[64], float* dst) {
#pragma unroll
    for (int i = 0; i < 16; ++i) *(float4*)(dst + i * 4) = make_float4(v[i * 4], v[i * 4 + 1], v[i * 4 + 2], v[i * 4 + 3]);
}
DEV void col_store_bf16(const float (&v)[64], u16* dst, size_t ld) {
#pragma unroll
    for (int c = 0; c < 64; ++c) dst[(size_t)c * ld] = f2bf(v[c]);
}

DEV void p1_tile(const Params& p, int l, int tile, char* lds, int tid) {
    char* ws = p.ws;
    const int tm = tile % 96, tn = tile / 96;
    const int lane = tid & 63, wid = __builtin_amdgcn_readfirstlane(tid >> 6), wr = wid >> 1, wc = wid & 1;
    float v[64];
    {
        f32x4 acc[4][4];
        zero_acc<4>(acc);
        gemm_mainloop<4>(acc, (const u16*)(ws + OFF_H) + (size_t)tm * 128 * 1024, 1024, (const u16*)(ws + OFF_WIN) + (size_t)tn * 128 * 1024, 1024, 1024, lds, tid);
        acc_to_rows(acc, lds, wid, lane, v);
    }
    const int t0 = tm * 128 + wr * 64;
    const bool lat = t0 >= 4096;
    const int bs = tok_bs(t0), n0 = tok_n(t0);
    const int t = t0 + lane, n = n0 + lane;
    char* wl = lds + wid * 16384;
    const float* tab = (const float*)(ws + OFF_ROPE);
    const int S = lat ? 4608 : 256;
    const int col = tn * 128 + wc * 64;
    if (tn < 4) {
        row_norm_rope(v, p.gqa_q_norm + l * 64, lat, n, tab, QSCALE);
        row_store_bf16(v, (u16*)(ws + OFF_QG) + (size_t)t0 * 512 + col, 512, wl, lane);
    } else if (tn == 4) {
        const int kv = wc;
        row_norm_rope(v, p.gqa_k_norm + l * 64, lat, n, tab, 1.0f);
        row_store_bf16(v, kg_ptr(ws, bs, kv) + (size_t)n0 * 64, 64, wl, lane);
        if (!lat) row_store_f32(v, p.out + OUT_GK + (size_t)((bs * 2 + l) * 256 + n) * 128 + kv * 64);
    } else if (tn == 5) {
        const int kv = wc;
        col_store_bf16(v, vgt_ptr(ws, bs, kv) + n, S);
        if (!lat) row_store_f32(v, p.out + OUT_GV + (size_t)((bs * 2 + l) * 256 + n) * 128 + kv * 64);
    } else if (tn < 8) {
#pragma unroll
        for (int c = 0; c < 64; ++c) v[c] *= 0.125f;
        row_store_bf16(v, (u16*)(ws + OFF_LQ) + (size_t)t0 * 256 + (col - 768), 256, wl, lane);
    } else if (tn < 10) {
        row_store_bf16(v, (u16*)(ws + OFF_LK) + (size_t)t0 * 256 + (col - 1024), 256, wl, lane);
    } else if (tn < 14) {
        const int c2 = col - 1280, h = c2 >> 7, e0 = c2 & 127;
        const int N = lat ? 4096 : 256;
        col_store_bf16(v, lvt_ptr(ws, bs, h) + (size_t)e0 * N + n, N);
    } else if (tn < 18) {
#pragma unroll
        for (int c = 0; c < 64; ++c) v[c] = siluf_(v[c]);
        row_store_bf16(v, (u16*)(ws + OFF_LGO) + (size_t)t0 * 512 + (col - 1792), 512, wl, lane);
    } else if (tn < 22) {
        row_norm_rope(v, p.diff_q_norm + l * 64, lat, n, tab, QSCALE);
        row_store_bf16(v, (u16*)(ws + OFF_QD) + (size_t)t0 * 512 + (col - 2304), 512, wl, lane);
    } else if (tn < 26) {
        const int hm = (col - 2816) >> 6;
        row_norm_rope(v, p.diff_k_norm + l * 64, lat, n, tab, 1.0f);
        row_store_bf16(v, kd_ptr(ws, bs, hm) + (size_t)n0 * 64, 64, wl, lane);
        if (!lat) row_store_f32(v, p.out + OUT_DK + (size_t)((bs * 2 + l) * 256 + n) * 512 + hm * 64);
    } else if (tn < 30) {
        const int c2 = col - 3328, h = c2 >> 7, e0 = c2 & 127;
        col_store_bf16(v, vdt_ptr(ws, bs, h) + (size_t)e0 * S + n, S);
        if (!lat) row_store_f32(v, p.out + OUT_DV + (size_t)((bs * 2 + l) * 256 + n) * 512 + c2);
    } else {
        if (wc == 0) {
            float* lr = (float*)(ws + OFF_LR) + (size_t)t * 32;
#pragma unroll
            for (int i = 0; i < 8; ++i) *(float4*)(lr + i * 4) = make_float4(v[i * 4], v[i * 4 + 1], v[i * 4 + 2], v[i * 4 + 3]);
        }
    }
    __syncthreads();
}

template <int DV>
DEV void attn_item(const u16* Qbase, int qcol, int trow0, const u16* Kp, const u16* VTp, int S, u16* Obase, int ostride, int ocol, char* lds, int tid) {
    const int lane = tid & 63, wid = __builtin_amdgcn_readfirstlane(tid >> 6), q = lane & 31, h = lane >> 5;
    constexpr int NDT = DV / 32;
    constexpr int KB = 64 * 128, VB = DV * 128;
    char* Kr = lds;
    char* Vr = lds + 3 * KB;
    bf16x8 qf[4];
#pragma unroll
    for (int ks = 0; ks < 4; ++ks) qf[ks] = *(const bf16x8*)(Qbase + (size_t)(trow0 + wid * 32 + q) * 512 + qcol + ks * 16 + h * 8);
    f32x16 o[NDT];
#pragma unroll
    for (int d = 0; d < NDT; ++d)
#pragma unroll
        for (int r = 0; r < 16; ++r) o[d][r] = 0.f;
    float m = 0.f, l = 0.f;
    float lo_thr = -8.0f;
    const int krow = (q & 19) | ((q & 4) << 1) | ((q & 8) >> 1);
    const int nt = S >> 6;
    auto qk = [&](f32x16 (&sc)[2], const char* kb) {
#pragma unroll
        for (int mt = 0; mt < 2; ++mt) {
            bf16x8 kf[4];
#pragma unroll
            for (int ks = 0; ks < 4; ++ks) kf[ks] = lds_frag1(kb, mt * 32 + krow, ks * 2 + h);
#pragma unroll
            for (int r = 0; r < 16; ++r) sc[mt][r] = 0.f;
#pragma unroll
            for (int ks = 0; ks < 4; ++ks) sc[mt] = mfma32(kf[ks], qf[ks], sc[mt]);
        }
    };
    auto step = [&](int it, f32x16 (&s)[2], f32x16 (&sn)[2]) {
        if (it > 0) { wait_vm0(); __syncthreads(); }
        if (it + 1 < nt) stage_rows<DV, 1>(VTp + (size_t)(it + 1) * 64, (unsigned)S, Vr + ((it + 1) & 1) * VB, tid);
        if (it + 2 < nt) stage_rows<64, 1>(Kp + (size_t)(it + 2) * 64 * 64, 64, Kr + ((it + 2) % 3) * KB, tid);
        qk(sn, Kr + ((it + 1) % 3) * KB);
        float mx = fmaxf(fmaxf(s[0][0], s[0][1]), s[0][2]);
#pragma unroll
        for (int r = 3; r < 15; r += 2) mx = fmaxf(fmaxf(mx, s[0][r]), s[0][r + 1]);
        mx = fmaxf(fmaxf(mx, s[0][15]), s[1][0]);
#pragma unroll
        for (int r = 1; r < 15; r += 2) mx = fmaxf(fmaxf(mx, s[1][r]), s[1][r + 1]);
        mx = fmaxf(mx, s[1][15]);
        mx = fmaxf(mx, __shfl_xor(mx, 32));
        const float rel = mx - m;
        const bool mv = rel > 8.0f || rel < lo_thr;
        lo_thr = -3.0e38f;
        if (__any(mv)) {
            const float delta = mv ? rel : 0.f;
            m += delta;
            const float alpha = delta > 0.f ? __builtin_amdgcn_exp2f(-delta) : 1.0f;
            l *= alpha;
#pragma unroll
            for (int d = 0; d < NDT; ++d) o[d] = o[d] * alpha;
        }
        if (__any(m != 0.f)) { s[0] = s[0] - m; s[1] = s[1] - m; }
#pragma unroll
        for (int mt = 0; mt < 2; ++mt)
#pragma unroll
            for (int r = 0; r < 16; ++r) s[mt][r] = __builtin_amdgcn_exp2f(s[mt][r]);
        {
            float a0 = s[0][0] + s[1][0], a1 = s[0][1] + s[1][1], a2 = s[0][2] + s[1][2], a3 = s[0][3] + s[1][3];
#pragma unroll
            for (int r = 4; r < 16; r += 4) { a0 += s[0][r] + s[1][r]; a1 += s[0][r + 1] + s[1][r + 1]; a2 += s[0][r + 2] + s[1][r + 2]; a3 += s[0][r + 3] + s[1][r + 3]; }
            l += (a0 + a1) + (a2 + a3);
        }
        bf16x8 pf[4];
#pragma unroll
        for (int kk = 0; kk < 4; ++kk) {
            const int mt = kk >> 1, t = (kk & 1) * 8;
            u32x4 w;
            w.x = pack2(s[mt][t], s[mt][t + 1]); w.y = pack2(s[mt][t + 2], s[mt][t + 3]);
            w.z = pack2(s[mt][t + 4], s[mt][t + 5]); w.w = pack2(s[mt][t + 6], s[mt][t + 7]);
            pf[kk] = __builtin_bit_cast(bf16x8, w);
        }
        asm volatile("" ::: "memory");
        const char* vb = Vr + (it & 1) * VB;
#pragma unroll
        for (int dt = 0; dt < NDT; ++dt) {
            bf16x8 vf[4];
#pragma unroll
            for (int kk = 0; kk < 4; ++kk) vf[kk] = lds_frag1(vb, dt * 32 + q, kk * 2 + h);
#pragma unroll
            for (int kk = 0; kk < 4; ++kk) o[dt] = mfma32(vf[kk], pf[kk], o[dt]);
        }
    };
    wait_vm0();
    stage_rows<64, 1>(Kp, 64, Kr, tid);
    stage_rows<DV, 1>(VTp, (unsigned)S, Vr, tid);
    stage_rows<64, 1>(Kp + (size_t)64 * 64, 64, Kr + KB, tid);
    wait_vm0();
    __syncthreads();
    f32x16 sa[2], sb[2];
    qk(sa, Kr);
    for (int it = 0; it < nt; it += 2) {
        step(it, sa, sb);
        step(it + 1, sb, sa);
    }
    __syncthreads();
    l += __shfl_xor(l, 32);
    const float inv = 1.0f / l;
    u16* orow = Obase + (size_t)(trow0 + wid * 32 + q) * ostride + ocol + 4 * h;
#pragma unroll
    for (int d = 0; d < NDT; ++d)
#pragma unroll
        for (int g = 0; g < 4; ++g)
            *(u32x2*)(orow + 32 * d + 8 * g) = (u32x2){pack2(o[d][4 * g] * inv, o[d][4 * g + 1] * inv), pack2(o[d][4 * g + 2] * inv, o[d][4 * g + 3] * inv)};
}

DEV void gla1_item(const Params& p, int l, int it, char* lds, int tid) {
    char* ws = p.ws;
    const int gch = it >> 2, h = it & 3;
    const int t0 = gch * 64;
    const int bs = tok_bs(t0), n0 = tok_n(t0);
    const int N = bs < 16 ? 256 : 4096;
    const int lane = tid & 63, wid = __builtin_amdgcn_readfirstlane(tid >> 6), fr = lane & 15, fq = lane >> 4;
    float* lrS = (float*)lds;
    char* vT = lds + 8192;
    char* Qd = lds + 24576;
    char* Ki = lds + 32768;
    char* KteT = lds + 40960;
    char* Am = lds + 49152;
    float* tot = (float*)(lds + 57344);
    stage_rows<128>(lvt_ptr(ws, bs, h) + n0, (unsigned)N, vT, tid);
    const int d = tid & 63, qt = __builtin_amdgcn_readfirstlane(tid >> 6);
    float4 lr0, lr1;
    {
        const float4* src = (const float4*)((const float*)(ws + OFF_LR) + (size_t)t0 * 32);
        lr0 = src[tid]; lr1 = src[tid + 256];
    }
    u16 qraw[16], kraw[16];
#pragma unroll
    for (int jj = 0; jj < 16; ++jj) {
        const size_t gi = (size_t)(t0 + qt * 16 + jj) * 256 + h * 64 + d;
        qraw[jj] = ((const u16*)(ws + OFF_LQ))[gi];
        kraw[jj] = ((const u16*)(ws + OFF_LK))[gi];
    }
    float up[16], upn[16];
#pragma unroll
    for (int r = 0; r < 16; ++r) up[r] = p.gla_alpha_up[((size_t)(l * 2) * 16 + r) * 256 + h * 64 + d];
    float bias = p.gla_alpha_bias[(l * 2) * 256 + h * 64 + d], biasn;
    ((float4*)lrS)[tid] = lr0;
    ((float4*)lrS)[tid + 256] = lr1;
    wait_vm0();
    __syncthreads();
    f32x4 oacc[8];
#pragma unroll
    for (int n = 0; n < 8; ++n) oacc[n] = (f32x4){0.f, 0.f, 0.f, 0.f};
#pragma unroll 1
    for (int dir = 0; dir < 2; ++dir) {
        const int cc = (gch * 4 + h) * 2 + dir;
#pragma unroll
        for (int r = 0; r < 16; ++r) upn[r] = p.gla_alpha_up[((size_t)(l * 2 + 1) * 16 + r) * 256 + h * 64 + d];
        biasn = p.gla_alpha_bias[(l * 2 + 1) * 256 + h * 64 + d];
        float la[16];
        float run = 0.f;
#pragma unroll
        for (int jj = 0; jj < 16; ++jj) {
            const float4* lp = (const float4*)(lrS + (qt * 16 + jj) * 32 + dir * 16);
            float z = bias;
#pragma unroll
            for (int r4 = 0; r4 < 4; ++r4) { const float4 x = lp[r4]; z += x.x * up[r4 * 4] + x.y * up[r4 * 4 + 1] + x.z * up[r4 * 4 + 2] + x.w * up[r4 * 4 + 3]; }
            la[jj] = (fminf(z, 0.f) - __logf(1.0f + __expf(-fabsf(z)))) * (1.0f / 16.0f);
            run += la[jj];
            asm volatile("" ::: "memory");
        }
        tot[qt * 64 + d] = run;
        __syncthreads();
        float offs = 0.f, total = 0.f;
#pragma unroll
        for (int q2 = 0; q2 < 4; ++q2) {
            const float tv = tot[q2 * 64 + d];
            total += tv;
            if (dir == 0 ? (q2 < qt) : (q2 > qt)) offs += tv;
        }
        float cpre = dir == 0 ? offs : offs + run;
#pragma unroll
        for (int j4 = 0; j4 < 4; ++j4) {
            float kt4[4];
#pragma unroll
            for (int u = 0; u < 4; ++u) {
                const int jj = j4 * 4 + u;
                const int j = qt * 16 + jj;
                float cv;
                if (dir == 0) { cpre += la[jj]; cv = cpre; } else { cv = cpre; cpre -= la[jj]; }
                const float qv = bf2f(qraw[jj]);
                const float kv = bf2f(kraw[jj]);
                const u16 qd = f2bf(qv * __expf(cv));
                const u16 ki = f2bf(kv * __expf(-cv));
                kt4[u] = kv * __expf(total - cv);
                const int so = j * 128 + ((((d >> 3) ^ (j & 7))) << 4) + (d & 7) * 2;
                *(u16*)(Qd + so) = qd;
                *(u16*)(Ki + so) = ki;
                ((u16*)(ws + OFF_QDG))[(size_t)dir * NTOK * 256 + (size_t)(t0 + j) * 256 + h * 64 + d] = qd;
                asm volatile("" ::: "memory");
            }
            const int j0 = qt * 16 + j4 * 4;
            *(u32x2*)(KteT + d * 128 + ((((j0 >> 3) ^ (d & 7))) << 4) + (j0 & 4) * 2) = (u32x2){pack2(kt4[0], kt4[1]), pack2(kt4[2], kt4[3])};
        }
        if (qt == 0) ((float*)(ws + OFF_DECAY))[(size_t)cc * 64 + d] = __expf(total);
        __syncthreads();
        {
            f32x4 sacc[4];
#pragma unroll
            for (int n = 0; n < 4; ++n) sacc[n] = (f32x4){0.f, 0.f, 0.f, 0.f};
#pragma unroll
            for (int ks = 0; ks < 2; ++ks) {
                const bf16x8 a = lds_frag(Qd, wid * 16 + fr, ks * 4 + fq);
#pragma unroll
                for (int n = 0; n < 4; ++n) sacc[n] = mfma16(a, lds_frag(Ki, n * 16 + fr, ks * 4 + fq), sacc[n]);
            }
#pragma unroll
            for (int n = 0; n < 4; ++n)
#pragma unroll
                for (int r = 0; r < 4; ++r) {
                    const int i = wid * 16 + fq * 4 + r, j = n * 16 + fr;
                    const bool keep = dir == 0 ? (j <= i) : (j >= i);
                    *(u16*)(Am + i * 128 + ((((j >> 3) ^ (i & 7))) << 4) + (j & 7) * 2) = keep ? f2bf(sacc[n][r]) : (u16)0;
                }
            f32x4 dacc[2][4];
#pragma unroll
            for (int mt = 0; mt < 2; ++mt)
#pragma unroll
                for (int n = 0; n < 4; ++n) dacc[mt][n] = (f32x4){0.f, 0.f, 0.f, 0.f};
#pragma unroll
            for (int ks = 0; ks < 2; ++ks) {
                bf16x8 b[4];
#pragma unroll
                for (int n = 0; n < 4; ++n) b[n] = lds_frag(KteT, n * 16 + fr, ks * 4 + fq);
#pragma unroll
                for (int mt = 0; mt < 2; ++mt) {
                    const bf16x8 a = lds_frag(vT, wid * 32 + mt * 16 + fr, ks * 4 + fq);
#pragma unroll
                    for (int n = 0; n < 4; ++n) dacc[mt][n] = mfma16(a, b[n], dacc[mt][n]);
                }
            }
            u16* dst = (u16*)(ws + OFF_DST) + (size_t)cc * 8192;
#pragma unroll
            for (int mt = 0; mt < 2; ++mt)
#pragma unroll
                for (int n = 0; n < 4; ++n)
#pragma unroll
                    for (int r = 0; r < 4; ++r) dst[(wid * 32 + mt * 16 + fq * 4 + r) * 64 + n * 16 + fr] = f2bf(dacc[mt][n][r]);
        }
        __syncthreads();
#pragma unroll
        for (int ks = 0; ks < 2; ++ks) {
            const bf16x8 a = lds_frag(Am, wid * 16 + fr, ks * 4 + fq);
#pragma unroll
            for (int n = 0; n < 8; ++n) oacc[n] = mfma16(a, lds_frag(vT, n * 16 + fr, ks * 4 + fq), oacc[n]);
        }
        __syncthreads();
#pragma unroll
        for (int r = 0; r < 16; ++r) up[r] = upn[r];
        bias = biasn;
    }
    u32x2* oi = (u32x2*)(ws + OFF_OI) + ((size_t)it * 4 + wid) * 8 * 64;
#pragma unroll
    for (int n = 0; n < 8; ++n) oi[n * 64 + lane] = (u32x2){pack2(oacc[n][0], oacc[n][1]), pack2(oacc[n][2], oacc[n][3])};
}

DEV void scan_item(const Params& p, int l, int it, int tid) {
    char* ws = p.ws;
    const u16* __restrict__ dst = (const u16*)(ws + OFF_DST);
    u16* __restrict__ sp = (u16*)(ws + OFF_SPREV);
    const float* __restrict__ dec = (const float*)(ws + OFF_DECAY);
    const int d = tid & 63, wv = __builtin_amdgcn_readfirstlane(tid >> 6);
    if (it < 512) {
        const int bs = 16 + (it >> 8), rem = it & 255;
        const int h = rem >> 6, dir = (rem >> 5) & 1, eb = rem & 31;
        const int e = eb * 4 + wv;
        const int gbase = 64 + (bs - 16) * 64;
        float s = p.state_gla[((size_t)((((bs - 16) * 2 + l) * 2 + dir) * 4 + h)) * 8192 + d * 128 + e];
#pragma unroll 1
        for (int st0 = 0; st0 < 64; st0 += 32) {
            float dv[32], xv[32];
#pragma unroll
            for (int u = 0; u < 32; ++u) {
                const int c = dir == 0 ? st0 + u : 63 - (st0 + u);
                const size_t ci = (size_t)((gbase + c) * 4 + h) * 2 + dir;
                dv[u] = dec[ci * 64 + d];
                xv[u] = bf2f(dst[ci * 8192 + e * 64 + d]);
            }
#pragma unroll
            for (int u = 0; u < 32; ++u) {
                const int c = dir == 0 ? st0 + u : 63 - (st0 + u);
                const size_t ci = (size_t)((gbase + c) * 4 + h) * 2 + dir;
                sp[ci * 8192 + e * 64 + d] = f2bf(s); s = dv[u] * s + xv[u];
            }
        }
    } else {
        const int i2 = it - 512, bs = i2 >> 5, rem = i2 & 31;
        const int h = rem >> 3, dir = (rem >> 2) & 1, eq = rem & 3;
        float dv[4];
        size_t cidx[4];
#pragma unroll
        for (int st = 0; st < 4; ++st) {
            const int c = dir == 0 ? st : 3 - st;
            cidx[st] = (size_t)((bs * 4 + c) * 4 + h) * 2 + dir;
            dv[st] = dec[cidx[st] * 64 + d];
        }
        float xv[8][4];
#pragma unroll
        for (int u = 0; u < 8; ++u)
#pragma unroll
            for (int st = 0; st < 4; ++st) xv[u][st] = bf2f(dst[cidx[st] * 8192 + ((eq * 8 + u) * 4 + wv) * 64 + d]);
#pragma unroll
        for (int u = 0; u < 8; ++u) {
            const int e = (eq * 8 + u) * 4 + wv;
            float s = 0.f;
#pragma unroll
            for (int st = 0; st < 4; ++st) { sp[cidx[st] * 8192 + e * 64 + d] = f2bf(s); s = dv[st] * s + xv[u][st]; }
            p.out[OUT_ST + ((size_t)(((bs * 2 + l) * 2 + dir) * 4 + h)) * 8192 + d * 128 + e] = s;
        }
    }
}

DEV void gla3_item(const Params& p, int l, int it, int tid) {
    char* ws = p.ws;
    const int gch = it >> 2, h = it & 3;
    const int t0 = gch * 64;
    const int lane = tid & 63, wid = __builtin_amdgcn_readfirstlane(tid >> 6), fr = lane & 15, fq = lane >> 4;
    f32x4 acc[8];
    const u32x2* oi = (const u32x2*)(ws + OFF_OI) + ((size_t)it * 4 + wid) * 8 * 64;
#pragma unroll
    for (int n = 0; n < 8; ++n) {
        const u32x2 w = oi[n * 64 + lane];
        acc[n] = (f32x4){__uint_as_float(w.x << 16), __uint_as_float(w.x & 0xffff0000u), __uint_as_float(w.y << 16), __uint_as_float(w.y & 0xffff0000u)};
    }
#pragma unroll
    for (int dir = 0; dir < 2; ++dir) {
        const size_t cc = (size_t)(gch * 4 + h) * 2 + dir;
        const u16* qd = (const u16*)(ws + OFF_QDG) + (size_t)dir * NTOK * 256 + (size_t)(t0 + wid * 16 + fr) * 256 + h * 64;
        const u16* sp = (const u16*)(ws + OFF_SPREV) + cc * 8192;
#pragma unroll
        for (int ks = 0; ks < 2; ++ks) {
            const bf16x8 a = *(const bf16x8*)(qd + ks * 32 + fq * 8);
#pragma unroll
            for (int n = 0; n < 8; ++n) {
                const bf16x8 b = *(const bf16x8*)(sp + (n * 16 + fr) * 64 + ks * 32 + fq * 8);
                acc[n] = mfma16(a, b, acc[n]);
            }
        }
    }
    float gn[8];
#pragma unroll
    for (int n = 0; n < 8; ++n) gn[n] = p.gla_out_norm[l * 128 + n * 16 + fr];
#pragma unroll
    for (int r = 0; r < 4; ++r) {
        float ss = 0.f;
#pragma unroll
        for (int n = 0; n < 8; ++n) ss += acc[n][r] * acc[n][r];
        ss += __shfl_xor(ss, 1); ss += __shfl_xor(ss, 2); ss += __shfl_xor(ss, 4); ss += __shfl_xor(ss, 8);
        const float rstd = rsqrtf(ss * (1.0f / 128.0f) + EPSV);
        const size_t t = (size_t)(t0 + wid * 16 + fq * 4 + r);
        const u16* g = (const u16*)(ws + OFF_LGO) + t * 512 + h * 128;
        u16* o = (u16*)(ws + OFF_GLAOUT) + t * 512 + h * 128;
#pragma unroll
        for (int n = 0; n < 8; ++n) o[n * 16 + fr] = f2bf(acc[n][r] * rstd * gn[n] * bf2f(g[n * 16 + fr]));
    }
}

DEV float diff_lambda_val(const Params& p, int l, int lane) {
    const float* lp = p.diff_lambda + l * 256;
    float a = lp[lane] * lp[64 + lane], b = lp[128 + lane] * lp[192 + lane];
#pragma unroll
    for (int o = 1; o < 64; o <<= 1) { a += __shfl_xor(a, o); b += __shfl_xor(b, o); }
    const float lam_init = l == 0 ? 0.2f : (0.8f - 0.6f * 0.7408182206817179f);
    return __expf(a) - __expf(b) + lam_init;
}

DEV void diffc_item(const Params& p, int l, int it, int tid) {
    char* ws = p.ws;
    const int lane = tid & 63, wid = __builtin_amdgcn_readfirstlane(tid >> 6);
    const float lam = diff_lambda_val(p, l, lane);
    const float lam_init = l == 0 ? 0.2f : (0.8f - 0.6f * 0.7408182206817179f);
    const float g0 = p.diff_sub_norm[l * 128 + 2 * lane] * (1.0f - lam_init), g1 = p.diff_sub_norm[l * 128 + 2 * lane + 1] * (1.0f - lam_init);
    unsigned w1[24], w2[24];
#pragma unroll
    for (int i = 0; i < 24; ++i) {
        const int row = it * 96 + wid * 24 + i;
        const int t = row >> 2, h = row & 3;
        w1[i] = *(const unsigned*)((const u16*)(ws + OFF_DIFFO) + (size_t)t * 1024 + (h * 2) * 128 + 2 * lane);
        w2[i] = *(const unsigned*)((const u16*)(ws + OFF_DIFFO) + (size_t)t * 1024 + (h * 2 + 1) * 128 + 2 * lane);
    }
#pragma unroll
    for (int i = 0; i < 24; ++i) {
        const int row = it * 96 + wid * 24 + i;
        const int t = row >> 2, h = row & 3;
        const float a0 = __uint_as_float(w1[i] << 16) - lam * __uint_as_float(w2[i] << 16);
        const float a1 = __uint_as_float(w1[i] & 0xffff0000u) - lam * __uint_as_float(w2[i] & 0xffff0000u);
        float ss = a0 * a0 + a1 * a1;
#pragma unroll
        for (int o = 1; o < 64; o <<= 1) ss += __shfl_xor(ss, o);
        const float rstd = rsqrtf(ss * (1.0f / 128.0f) + EPSV);
        *(unsigned*)((u16*)(ws + OFF_DIFFOUT) + (size_t)t * 512 + h * 128 + 2 * lane) = pack2(a0 * rstd * g0, a1 * rstd * g1);
    }
}

DEV void p5_tile(const Params& p, int l, int tile, char* lds, int tid) {
    char* ws = p.ws;
    const int xk = tile >> 3, tm = (tile & 7) * 12 + (xk >> 4), tn = xk & 15;
    const int lane = tid & 63, wid = __builtin_amdgcn_readfirstlane(tid >> 6), wr = wid >> 1, wc = wid & 1, fr = lane & 15, fq = lane >> 4;
    f32x4 tot[4][2];
    zero_acc<2>(tot);
    for (int i = 0; i < 3; ++i) {
        f32x4 g[4][2];
        zero_acc<2>(g);
        gemm_mainloop<2, true>(g, (const u16*)(ws + OFF_H) + (size_t)tm * 128 * 1024, 1024, (const u16*)(ws + OFF_WIN) + (size_t)(3968 + i * 1024 + tn * 64) * 1024, 1024, 1024, lds, tid);
#pragma unroll
        for (int m = 0; m < 4; ++m)
#pragma unroll
            for (int n = 0; n < 2; ++n)
#pragma unroll
                for (int j = 0; j < 4; ++j) g[m][n][j] = sigmoidf_(g[m][n][j]);
        f32x4 y[4][2];
        zero_acc<2>(y);
        const u16* bo = (const u16*)(ws + (i == 0 ? OFF_QG : (i == 1 ? OFF_GLAOUT : OFF_DIFFOUT)));
        gemm_mainloop<2, true>(y, bo + (size_t)tm * 128 * 512, 512, (const u16*)(ws + OFF_WBR) + (size_t)(i * 1024 + tn * 64) * 512, 512, 512, lds, tid);
#pragma unroll
        for (int m = 0; m < 4; ++m)
#pragma unroll
            for (int n = 0; n < 2; ++n) tot[m][n] = tot[m][n] + g[m][n] * y[m][n];
    }
    u16* dst = (u16*)(ws + OFF_MIXED) + (size_t)(tm * 128 + wr * 64 + fr) * 1024 + tn * 64 + wc * 32 + fq * 4;
#pragma unroll
    for (int m = 0; m < 4; ++m)
#pragma unroll
        for (int n = 0; n < 2; ++n)
            *(u32x2*)(dst + (size_t)m * 16 * 1024 + n * 16) = (u32x2){pack2(tot[m][n][0], tot[m][n][1]), pack2(tot[m][n][2], tot[m][n][3])};
}

DEV void resid_tile(const Params& p, int l, int which, int tile, char* lds, int tid, int fuse) {
    char* ws = p.ws;
    const int xk = tile >> 3, tm = (tile & 7) * 12 + (xk >> 4), tn = xk & 15;
    const int lane = tid & 63, wid = __builtin_amdgcn_readfirstlane(tid >> 6), wr = wid >> 1, wc = wid & 1, fr = lane & 15, fq = lane >> 4;
    f32x4 acc[4][2];
    zero_acc<2>(acc);
    if (which == 0) gemm_mainloop3<2, true>(acc, (const u16*)(ws + OFF_MIXED) + (size_t)tm * 128 * 1024, 1024, (const u16*)(ws + OFF_WOUT) + (size_t)tn * 64 * 1024, 1024, 1024, lds, tid);
    else gemm_mainloop3<2, true>(acc, (const u16*)(ws + OFF_ACT) + (size_t)tm * 128 * FFH, FFH, (const u16*)(ws + OFF_WFO) + (size_t)tn * 64 * FFH, FFH, FFH, lds, tid);
    const int t0 = tm * 128 + wr * 64;
    const float* gate = (const float*)(ws + OFF_MOD) + (size_t)(l * 3 + tok_cond(t0)) * 6144 + (which == 0 ? 2048 : 5120);
    const int c0 = tn * 64 + wc * 32 + fq * 4;
    float4 gv[2];
    gv[0] = *(const float4*)(gate + c0); gv[1] = *(const float4*)(gate + c0 + 16);
#pragma unroll
    for (int m = 0; m < 4; ++m) {
        const int t = t0 + m * 16 + fr;
        const bool in_f32 = (which == 0 && l == 0);
        const bool out_f32 = (which == 1 && l == 1);
        const float* xin = t < 4096 ? p.x_prompt + (size_t)t * 1024 : p.x_sample + (size_t)(t - 4096) * 1024;
        u16* xb = (u16*)(ws + OFF_XB) + (size_t)t * 1024;
        float* xo = p.out + (size_t)t * 1024;
#pragma unroll
        for (int n = 0; n < 2; ++n) {
            float4 xi;
            if (in_f32) xi = *(const float4*)(xin + c0 + n * 16);
            else {
                const u32x2 w = *(const u32x2*)(xb + c0 + n * 16);
                xi = make_float4(__uint_as_float(w.x << 16), __uint_as_float(w.x & 0xffff0000u), __uint_as_float(w.y << 16), __uint_as_float(w.y & 0xffff0000u));
            }
            f32x4 v;
            v[0] = xi.x + gv[n].x * acc[m][n][0]; v[1] = xi.y + gv[n].y * acc[m][n][1]; v[2] = xi.z + gv[n].z * acc[m][n][2]; v[3] = xi.w + gv[n].w * acc[m][n][3];
            if (out_f32) *(f32x4*)(xo + c0 + n * 16) = v;
            else *(u32x2*)(xb + c0 + n * 16) = (u32x2){pack2(v[0], v[1]), pack2(v[2], v[3])};
        }
    }
    if (fuse >= 0) {
        volatile LAS unsigned* flag = (volatile LAS unsigned*)(lds + 73728 + 8);
        asm volatile("s_waitcnt vmcnt(0)" ::: "memory");
        __syncthreads();
        if (tid == 0) {
            const unsigned old = __hip_atomic_fetch_add((unsigned*)(ws + OFF_CNT) + fuse * 128 + tm, 1u, __ATOMIC_RELAXED, __HIP_MEMORY_SCOPE_AGENT);
            const unsigned last = (old == 15u) ? 1u : 0u;
            if (last) { __builtin_amdgcn_fence(__ATOMIC_ACQUIRE, "agent"); asm volatile("s_waitcnt vmcnt(0)" ::: "memory"); }
            flag[0] = last;
        }
        __syncthreads();
        const unsigned last = flag[0];
        if (last) {
#pragma unroll 1
            for (int i = 0; i < 4; ++i) {
                if (which == 0) norm_item<8>(p, l, 1, tm * 4 + i, tid);
                else norm_item<8>(p, l + 1, 0, tm * 4 + i, tid);
            }
        }
        __syncthreads();
    }
}

template <int ROWS>
DEV void stage32(const u16* g, unsigned ld, char* lds, int tid) {
    const int wbase = __builtin_amdgcn_readfirstlane(tid >> 6) * 64;
    const char* gb = (const char*)g;
#pragma unroll
    for (int i = 0; i < ROWS / 64; ++i) {
        const int idx = tid + i * 256;
        const int r = idx >> 2, sl = idx & 3;
        const int c = sl ^ (((r >> 3) & 1) << 1);
        const unsigned off = ((unsigned)r * ld + (unsigned)c * 8u) * 2u;
        __builtin_amdgcn_global_load_lds((const void*)(gb + off), (LAS void*)(lds + (wbase + i * 256) * 16), 16, 0, 0);
    }
}
DEV bf16x8 frag32(const char* tile, int row, int chunk) { return *(const bf16x8*)(tile + row * 64 + ((chunk ^ (((row >> 3) & 1) << 1)) << 4)); }

DEV void resid192_tile(const Params& p, int l, int which, int tile, char* lds, int tid) {
    char* ws = p.ws;
    const int xk = tile >> 3, tm = (tile & 7) * 8 + (xk >> 3), tn = xk & 7;
    const int lane = tid & 63, wid = __builtin_amdgcn_readfirstlane(tid >> 6), wr = wid >> 1, wc = wid & 1, fr = lane & 15, fq = lane >> 4;
    constexpr int AB = 192 * 64, BB = 128 * 64, STG = AB + BB;
    const u16* A; const u16* B; unsigned ld; int K;
    if (which == 0) { A = (const u16*)(ws + OFF_MIXED) + (size_t)tm * 192 * 1024; B = (const u16*)(ws + OFF_WOUT) + (size_t)tn * 128 * 1024; ld = 1024; K = 1024; }
    else { A = (const u16*)(ws + OFF_ACT) + (size_t)tm * 192 * FFH; B = (const u16*)(ws + OFF_WFO) + (size_t)tn * 128 * FFH; ld = FFH; K = FFH; }
    const int nk = K >> 5;
    f32x4 acc[6][4];
#pragma unroll
    for (int m = 0; m < 6; ++m)
#pragma unroll
        for (int n = 0; n < 4; ++n) acc[m][n] = (f32x4){0.f, 0.f, 0.f, 0.f};
    wait_vm0();
    stage32<192>(A, ld, lds, tid);
    stage32<128>(B, ld, lds + AB, tid);
    stage32<192>(A + 32, ld, lds + STG, tid);
    stage32<128>(B + 32, ld, lds + STG + AB, tid);
    int cb = 0;
    for (int kt = 0; kt < nk; ++kt) {
        char* cur = lds + cb * STG;
        if (kt + 1 < nk) asm volatile("s_waitcnt vmcnt(5)" ::: "memory");
        else asm volatile("s_waitcnt vmcnt(0)" ::: "memory");
        asm volatile("s_waitcnt lgkmcnt(0)" ::: "memory");
        __builtin_amdgcn_s_barrier();
        asm volatile("" ::: "memory");
        if (kt + 2 < nk) {
            char* nxt = lds + (cb == 0 ? 2 : cb - 1) * STG;
            stage32<192>(A + (size_t)(kt + 2) * 32, ld, nxt, tid);
            stage32<128>(B + (size_t)(kt + 2) * 32, ld, nxt + AB, tid);
        }
        bf16x8 a[6], b[4];
#pragma unroll
        for (int m = 0; m < 6; ++m) a[m] = frag32(cur, wr * 96 + m * 16 + fr, fq);
#pragma unroll
        for (int n = 0; n < 4; ++n) b[n] = frag32(cur + AB, wc * 64 + n * 16 + fr, fq);
        __builtin_amdgcn_sched_barrier(0);
#pragma unroll
        for (int m = 0; m < 6; ++m)
#pragma unroll
            for (int n = 0; n < 4; ++n) acc[m][n] = mfma16(b[n], a[m], acc[m][n]);
        cb = cb == 2 ? 0 : cb + 1;
    }
    __syncthreads();
    const bool in_f32 = (which == 0 && l == 0), out_f32 = (which == 1 && l == 1);
    const int c0 = tn * 128 + wc * 64 + fq * 4;
#pragma unroll
    for (int m = 0; m < 6; ++m) {
        const int t = tm * 192 + wr * 96 + m * 16 + fr;
        const float* gate = (const float*)(ws + OFF_MOD) + (size_t)(l * 3 + tok_cond(t)) * 6144 + (which == 0 ? 2048 : 5120);
        const float* xin = t < 4096 ? p.x_prompt + (size_t)t * 1024 : p.x_sample + (size_t)(t - 4096) * 1024;
        u16* xb = (u16*)(ws + OFF_XB) + (size_t)t * 1024;
        float* xo = p.out + (size_t)t * 1024;
#pragma unroll
        for (int n = 0; n < 4; ++n) {
            const float4 gv = *(const float4*)(gate + c0 + n * 16);
            float4 xi;
            if (in_f32) xi = *(const float4*)(xin + c0 + n * 16);
            else {
                const u32x2 w = *(const u32x2*)(xb + c0 + n * 16);
                xi = make_float4(__uint_as_float(w.x << 16), __uint_as_float(w.x & 0xffff0000u), __uint_as_float(w.y << 16), __uint_as_float(w.y & 0xffff0000u));
            }
            f32x4 v;
            v[0] = xi.x + gv.x * acc[m][n][0]; v[1] = xi.y + gv.y * acc[m][n][1]; v[2] = xi.z + gv.z * acc[m][n][2]; v[3] = xi.w + gv.w * acc[m][n][3];
            if (out_f32) *(f32x4*)(xo + c0 + n * 16) = v;
            else *(u32x2*)(xb + c0 + n * 16) = (u32x2){pack2(v[0], v[1]), pack2(v[2], v[3])};
        }
    }
}

DEV void p8_tile(const Params& p, int l, int tile, char* lds, int tid, int rep = 0) {
    char* ws = p.ws;
    const int tm = tile % 96, tn = tile / 96;
    const int lane = tid & 63, wid = __builtin_amdgcn_readfirstlane(tid >> 6), wr = wid >> 1, wc = wid & 1, fr = lane & 15, fq = lane >> 4;
    f32x4 acc[4][4];
    zero_acc<4>(acc);
    gemm_mainloop<4, true>(acc, (const u16*)(ws + OFF_H) + (size_t)tm * 128 * 1024, 1024, (const u16*)(ws + OFF_WFI) + (size_t)tn * 128 * 1024, 1024, 1024, lds, tid);
    u16* dst = (u16*)(ws + OFF_ACT) + (size_t)(tm * 128 + wr * 64 + fr) * FFH + tn * 64 + wc * 32 + fq * 4;
#pragma unroll
    for (int m = 0; m < 4; ++m)
#pragma unroll
        for (int n = 0; n < 2; ++n) {
            const f32x4 a = acc[m][n], u = acc[m][n + 2];
            *(u32x2*)(dst + (size_t)m * 16 * FFH + n * 16) = (u32x2){pack2(siluf_(a[0]) * u[0], siluf_(a[1]) * u[1]), pack2(siluf_(a[2]) * u[2], siluf_(a[3]) * u[3])};
        }
}

DEV void p5_phase(const Params& p, int l, char* lds) {
    char* ws = p.ws;
    const int nitems = 96 * 16;
    int par = 0; int pre = 0;
    for (int it = blockIdx.x; it < nitems; it += gridDim.x) {
        int tid = threadIdx.x;
        asm volatile("" : "+v"(tid));
        const int lane = tid & 63, wid = __builtin_amdgcn_readfirstlane(tid >> 6), wr = wid >> 1, wc = wid & 1, fr = lane & 15, fq = lane >> 4;
        const int xk = it >> 3, tm = (it & 7) * 12 + (xk >> 4), tn = xk & 15;
        const int nit = it + gridDim.x; const bool hn = nit < nitems;
        const int nxk = nit >> 3, ntm = (nit & 7) * 12 + (nxk >> 4), ntn = nxk & 15;
        const u16* Hp = (const u16*)(ws + OFF_H);
        const u16* Wg = (const u16*)(ws + OFF_WIN) + (size_t)3968 * 1024;
        const u16* Wb = (const u16*)(ws + OFF_WBR);
        f32x4 tot[4][2];
        zero_acc<2>(tot);
#pragma unroll 1
        for (int i = 0; i < 3; ++i) {
            const u16* bo = (const u16*)(ws + (i == 0 ? OFF_QG : (i == 1 ? OFF_GLAOUT : OFF_DIFFOUT)));
            const u16* gA = Hp + (size_t)tm * 128 * 1024, *gB = Wg + (size_t)(i * 1024 + tn * 64) * 1024;
            const u16* yA = bo + (size_t)tm * 128 * 512, *yB = Wb + (size_t)(i * 1024 + tn * 64) * 512;
            f32x4 g[4][2];
            zero_acc<2>(g);
            gemm_chain2<2, true>(g, gA, 1024, gB, 1024, 1024, true, yA, 512, yB, 512, par, pre, lds, tid);
#pragma unroll
            for (int m = 0; m < 4; ++m)
#pragma unroll
                for (int n = 0; n < 2; ++n)
#pragma unroll
                    for (int j = 0; j < 4; ++j) g[m][n][j] = sigmoidf_(g[m][n][j]);
            const bool hx = i < 2 ? true : hn;
            const u16* xA = i < 2 ? gA : Hp + (size_t)ntm * 128 * 1024;
            const u16* xB = i < 2 ? Wg + (size_t)((i + 1) * 1024 + tn * 64) * 1024 : Wg + (size_t)(ntn * 64) * 1024;
            f32x4 y[4][2];
            zero_acc<2>(y);
            gemm_chain2<2, true>(y, yA, 512, yB, 512, 512, hx, xA, 1024, xB, 1024, par, pre, lds, tid);
#pragma unroll
            for (int m = 0; m < 4; ++m)
#pragma unroll
                for (int n = 0; n < 2; ++n) tot[m][n] = tot[m][n] + g[m][n] * y[m][n];
        }
        u16* dst = (u16*)(ws + OFF_MIXED) + (size_t)(tm * 128 + wr * 64 + fr) * 1024 + tn * 64 + wc * 32 + fq * 4;
#pragma unroll
        for (int m = 0; m < 4; ++m)
#pragma unroll
            for (int n = 0; n < 2; ++n)
                *(u32x2*)(dst + (size_t)m * 16 * 1024 + n * 16) = (u32x2){pack2(tot[m][n][0], tot[m][n][1]), pack2(tot[m][n][2], tot[m][n][3])};
    }
}

DEV void p8_phase(const Params& p, int l, char* lds) {
    char* ws = p.ws;
    const int nitems = 96 * 44;
    int par = 0; int pre = 0;
    for (int it = blockIdx.x; it < nitems; it += gridDim.x) {
        int tid = threadIdx.x;
        asm volatile("" : "+v"(tid));
        const int lane = tid & 63, wid = __builtin_amdgcn_readfirstlane(tid >> 6), wr = wid >> 1, wc = wid & 1, fr = lane & 15, fq = lane >> 4;
        const int tm = it % 96, tn = it / 96;
        const int nit = it + gridDim.x; const bool hn = nit < nitems;
        const int ntm = nit % 96, ntn = nit / 96;
        f32x4 acc[4][4];
        zero_acc<4>(acc);
        gemm_chain2<4, true>(acc, (const u16*)(ws + OFF_H) + (size_t)tm * 128 * 1024, 1024, (const u16*)(ws + OFF_WFI) + (size_t)tn * 128 * 1024, 1024, 1024,
                            hn, (const u16*)(ws + OFF_H) + (size_t)ntm * 128 * 1024, 1024, (const u16*)(ws + OFF_WFI) + (size_t)ntn * 128 * 1024, 1024, par, pre, lds, tid);
        u16* dst = (u16*)(ws + OFF_ACT) + (size_t)(tm * 128 + wr * 64 + fr) * FFH + tn * 64 + wc * 32 + fq * 4;
#pragma unroll
        for (int m = 0; m < 4; ++m)
#pragma unroll
            for (int n = 0; n < 2; ++n) {
                const f32x4 a = acc[m][n], u = acc[m][n + 2];
                *(u32x2*)(dst + (size_t)m * 16 * FFH + n * 16) = (u32x2){pack2(siluf_(a[0]) * u[0], siluf_(a[1]) * u[1]), pack2(siluf_(a[2]) * u[2], siluf_(a[3]) * u[3])};
            }
    }
    if (l == 0) {
        const int rem = nitems % (int)gridDim.x;
        const int first = rem == 0 ? 0 : rem, nidle = (int)gridDim.x - first;
        if ((int)blockIdx.x >= first)
            for (int j = (int)blockIdx.x - first; j < NCONV_EARLY; j += nidle) {
                int tid = threadIdx.x;
                asm volatile("" : "+v"(tid));
                conv_item(p, 1, j, lds, tid);
            }
    }
}

DEV void p2_phase(const Params& p, int l, char* lds) {
    char* ws = p.ws;
    for (int it = blockIdx.x; it < 1024; it += gridDim.x) {
        int tid = threadIdx.x;
        asm volatile("" : "+v"(tid));
        if (it < 512) {
            const int j = it & 7, r = it >> 3, b = j >> 2, hm = (j & 3) * 2 + (r >> 5), qb = r & 31, bs = 16 + b;
            attn_item<128>((const u16*)(ws + OFF_QD), hm * 64, 4096 + b * 4096 + qb * 128, kd_ptr(ws, bs, hm), vdt_ptr(ws, bs, hm >> 1), 4608, (u16*)(ws + OFF_DIFFO), 1024, hm * 128, lds, tid);
        } else {
            const int i2 = it - 512, j = i2 & 7, r = i2 >> 3, b = j >> 2, kvh = (j >> 1) & 1, hh = kvh * 4 + (j & 1) * 2 + (r >> 5), qb = r & 31, bs = 16 + b;
            attn_item<64>((const u16*)(ws + OFF_QG), hh * 64, 4096 + b * 4096 + qb * 128, kg_ptr(ws, bs, hh >> 2), vgt_ptr(ws, bs, hh >> 2), 4608, (u16*)(ws + OFF_QG), 512, hh * 64, lds, tid);
        }
    }
    volatile LAS unsigned* flag = (volatile LAS unsigned*)(lds + 73728 + 8);
    unsigned* cnt = (unsigned*)(ws + OFF_CNT) + l * 64;
    for (;;) {
        int tid = threadIdx.x;
        asm volatile("" : "+v"(tid));
        __syncthreads();
        if (tid == 0) flag[0] = __hip_atomic_fetch_add(cnt, 1u, __ATOMIC_RELAXED, __HIP_MEMORY_SCOPE_AGENT);
        __syncthreads();
        const int j = __builtin_amdgcn_readfirstlane((int)flag[0]);
        if (j >= 1280) break;
        if (j < 768) gla1_item(p, l, j, lds, tid);
        else {
            const int i2 = j - 768, bs = i2 >> 5, ty = (i2 >> 4) & 1, hh = (i2 >> 1) & 7, qb = i2 & 1;
            if (ty == 0) attn_item<128>((const u16*)(ws + OFF_QD), hh * 64, bs * 256 + qb * 128, kd_ptr(ws, bs, hh), vdt_ptr(ws, bs, hh >> 1), 256, (u16*)(ws + OFF_DIFFO), 1024, hh * 128, lds, tid);
            else attn_item<64>((const u16*)(ws + OFF_QG), hh * 64, bs * 256 + qb * 128, kg_ptr(ws, bs, hh >> 2), vgt_ptr(ws, bs, hh >> 2), 256, (u16*)(ws + OFF_QG), 512, hh * 64, lds, tid);
        }
    }
}

#define XB_TMO      128
#define XB_XCNT(j)  (256  + 64 * (j))
#define XB_XSUB(j)  (1280 + 64 * (j))
#define XB_XGEN(j)  (2304 + 64 * (j))
#define XB_TOP      3328
#define XB_TOPGEN   3392
#define XCD_BAR_WORDS 3456
#define XB_SPIN_CAP (1u << 22)
DEV unsigned xb_ld(unsigned* p) { return __hip_atomic_load(p, __ATOMIC_RELAXED, __HIP_MEMORY_SCOPE_AGENT); }
DEV unsigned xb_add(unsigned* p, unsigned v) { return __hip_atomic_fetch_add(p, v, __ATOMIC_RELAXED, __HIP_MEMORY_SCOPE_AGENT); }
DEV unsigned xb_xcc_id() { return (unsigned)__builtin_amdgcn_s_getreg((3 << 11) | 20) & 0xFu; }
#define XB_SPIN(cond, bar) do { unsigned _sp = 0; while (cond) { __builtin_amdgcn_s_sleep(1); \
    if ((++_sp & 255u) == 0u) { if (xb_ld(&(bar)[XB_TMO])) break; if (_sp > XB_SPIN_CAP) { atomicAdd(&(bar)[XB_TMO], 1u); break; } } } } while (0)
struct XcdBarrier { unsigned* bar; unsigned x; volatile LAS unsigned* st; };
DEV XcdBarrier xcd_barrier_post(unsigned* bar, volatile LAS unsigned* st) {
    XcdBarrier b; b.bar = bar; b.x = xb_xcc_id(); b.st = st;
    if (threadIdx.x == 0) (void)xb_add(&bar[XB_XCNT(b.x)], 1u);
    return b;
}
DEV void xcd_barrier_complete(unsigned* bar, unsigned x, unsigned& nloc, unsigned& nx) {
    const unsigned G = gridDim.x * gridDim.y * gridDim.z;
    unsigned sum, cnt, mine, sp = 0u;
    for (;;) {
        sum = 0u; cnt = 0u; mine = 0u;
#pragma unroll
        for (unsigned j = 0; j < 16; ++j) { const unsigned c = xb_ld(&bar[XB_XCNT(j)]); sum += c; cnt += (c > 0u) ? 1u : 0u; mine = (j == x) ? c : mine; }
        if (sum == G) break;
        __builtin_amdgcn_s_sleep(1);
        if ((++sp & 255u) == 0u) { if (xb_ld(&bar[XB_TMO])) break; if (sp > XB_SPIN_CAP) { atomicAdd(&bar[XB_TMO], 1u); break; } }
    }
    nloc = mine > 0u ? mine : 1u; nx = cnt > 0u ? cnt : 1u;
}
DEV void xcd_barrier(const XcdBarrier& b) {
    asm volatile("s_waitcnt vmcnt(0)" ::: "memory");
    __syncthreads();
    if (threadIdx.x == 0) {
        unsigned* bar = b.bar;
        __builtin_amdgcn_s_waitcnt(0);
        unsigned nloc = b.st[0], nx = b.st[1];
        if (nloc == 0u) { xcd_barrier_complete(bar, b.x, nloc, nx); b.st[0] = nloc; b.st[1] = nx; }
        const unsigned old = xb_add(&bar[XB_XSUB(b.x)], 1u);
        const unsigned gen = old / nloc;
        if (old + 1u == (gen + 1u) * nloc) {
            __builtin_amdgcn_fence(__ATOMIC_RELEASE, "agent");
            asm volatile("s_waitcnt vmcnt(0)" ::: "memory");
            const unsigned og = xb_add(&bar[XB_TOP], 1u);
            const unsigned tg = og / nx;
            if (og + 1u == (tg + 1u) * nx) xb_add(&bar[XB_TOPGEN], 1u);
            else XB_SPIN(xb_ld(&bar[XB_TOPGEN]) == tg, bar);
            __builtin_amdgcn_fence(__ATOMIC_ACQUIRE, "agent");
            xb_add(&bar[XB_XGEN(b.x)], 1u);
            asm volatile("s_waitcnt vmcnt(0)" ::: "memory");
        } else {
            XB_SPIN(xb_ld(&bar[XB_XGEN(b.x)]) == gen, bar);
            __builtin_amdgcn_fence(__ATOMIC_ACQUIRE, "agent");
            asm volatile("s_waitcnt vmcnt(0)" ::: "memory");
        }
    }
    __syncthreads();
}

constexpr int NPHASE = 21;
__host__ __device__ inline int phase_items(int ph) {
    if (ph == 0) return NCONV + NMOD + 1 + NCACHE;
    const int l = (ph - 1) / 10, k = (ph - 1) % 10;
    switch (k) {
        case 0: return 384 + (l == 1 ? (NCONV - NCONV_EARLY) + NCACHE : 0);
        case 1: return 96 * 31;
        case 2: return 512 + 512 + 512 + 768;
        case 3: return 512 + 512;
        case 4: return 768 + 768;
        case 5: return 96 * 16;
        case 6: return 512;
        case 7: return 384;
        case 8: return 96 * 44;
        default: return 512;
    }
}

DEV void run_phase(const Params& p, int ph, char* lds, int rep = 0) {
    const int nitems = phase_items(ph);
    char* ws = p.ws;
    if (ph == 0) {
        for (int it = blockIdx.x; it < nitems; it += gridDim.x) {
            int tid = threadIdx.x;
            asm volatile("" : "+v"(tid));
            if (it < NCONV) conv_item(p, 0, it, lds, tid);
            else if (it < NCONV + NMOD) mod_item(p, it - NCONV, lds, tid);
            else if (it == NCONV + NMOD) rope_item(p, tid);
            else cache_item(p, 0, it - (NCONV + NMOD + 1), tid);
        }
        return;
    }
    const int l = (ph - 1) / 10, k = (ph - 1) % 10;
    if (k == 2) { p2_phase(p, l, lds); return; }
    if (k == 5) { p5_phase(p, l, lds); return; }
    if (k == 8) { p8_phase(p, l, lds); return; }
    for (int it = blockIdx.x; it < nitems; it += gridDim.x) {
        int tid = threadIdx.x;
        asm volatile("" : "+v"(tid));
        switch (k) {
            case 0:
                if (it < 384) norm_item<8>(p, l, 0, it, tid);
                else if (it < 384 + (NCONV - NCONV_EARLY)) conv_item(p, 1, NCONV_EARLY + (it - 384), lds, tid);
                else cache_item(p, 1, it - 384 - (NCONV - NCONV_EARLY), tid);
                break;
            case 1: p1_tile(p, l, it, lds, tid); break;
            case 2: {
                if (rep && ((it >= 512 && it < 1024) || (it >= 1024 && it < 1536 && ((it >> 4) & 1)))) break;
                if (it < 512) {
                    const int j = it & 7, r = it >> 3, b = j >> 2, hm = (j & 3) * 2 + (r >> 5), qb = r & 31, bs = 16 + b;
                    attn_item<128>((const u16*)(ws + OFF_QD), hm * 64, 4096 + b * 4096 + qb * 128, kd_ptr(ws, bs, hm), vdt_ptr(ws, bs, hm >> 1), 4608, (u16*)(ws + OFF_DIFFO), 1024, hm * 128, lds, tid);
                } else if (it < 1024) {
                    const int i2 = it - 512, j = i2 & 7, r = i2 >> 3, b = j >> 2, kvh = (j >> 1) & 1, hh = kvh * 4 + (j & 1) * 2 + (r >> 5), qb = r & 31, bs = 16 + b;
                    attn_item<64>((const u16*)(ws + OFF_QG), hh * 64, 4096 + b * 4096 + qb * 128, kg_ptr(ws, bs, hh >> 2), vgt_ptr(ws, bs, hh >> 2), 4608, (u16*)(ws + OFF_QG), 512, hh * 64, lds, tid);
                } else if (it < 1536) {
                    const int i2 = it - 1024, bs = i2 >> 5, ty = (i2 >> 4) & 1, hh = (i2 >> 1) & 7, qb = i2 & 1;
                    if (ty == 0) attn_item<128>((const u16*)(ws + OFF_QD), hh * 64, bs * 256 + qb * 128, kd_ptr(ws, bs, hh), vdt_ptr(ws, bs, hh >> 1), 256, (u16*)(ws + OFF_DIFFO), 1024, hh * 128, lds, tid);
                    else attn_item<64>((const u16*)(ws + OFF_QG), hh * 64, bs * 256 + qb * 128, kg_ptr(ws, bs, hh >> 2), vgt_ptr(ws, bs, hh >> 2), 256, (u16*)(ws + OFF_QG), 512, hh * 64, lds, tid);
                } else gla1_item(p, l, it - 1536, lds, tid);
                break;
            }
            case 3: scan_item(p, l, it, tid); break;
            case 4:
                if (it < 768) gla3_item(p, l, it, tid);
                else { const int j = it - 768, di = j < 256 ? j : (j >= 512 ? j - 256 : -1); if (di >= 0) diffc_item(p, l, di, tid); }
                break;
            case 5: p5_tile(p, l, it, lds, tid); break;
            case 6: resid192_tile(p, l, 0, it, lds, tid); break;
            case 7: norm_item<8>(p, l, 1, it, tid); break;
            case 8: p8_tile(p, l, it, lds, tid); break;
            default: resid192_tile(p, l, 1, it, lds, tid); break;
        }
    }
}

__global__ void __launch_bounds__(256, 2) fwd_kernel(Params p) {
    __shared__ __attribute__((aligned(16))) char lds[73728 + 16];
#ifdef ONE_LAUNCH
    volatile LAS unsigned* st = (volatile LAS unsigned*)(lds + 73728);
    if (threadIdx.x == 0) { st[0] = 0u; st[1] = 0u; }
    __syncthreads();
    XcdBarrier xb = xcd_barrier_post((unsigned*)(p.ws + OFF_BAR), st);
    if (p.pad0 == 0x7fffffff) cg::this_grid().sync();
#endif
    for (int ph = p.phase_lo; ph <= p.phase_hi; ++ph) {
        if (phase_items(ph) == 0) continue;
#ifdef PROBE_REP
        if (ph > 0 && ((PROBE_REP >> ((ph - 1) % 10)) & 1)) { run_phase(p, ph, lds, 1); xcd_barrier(xb); }
#endif
        run_phase(p, ph, lds);
#ifdef ONE_LAUNCH
        if (ph < p.phase_hi) xcd_barrier(xb);
#endif
    }
}

extern "C" void kernel_launch(void* const* d_in, const int* in_sizes, int n_in, void* d_out, int out_size, void* d_ws, size_t ws_size, hipStream_t stream) {
    Params p{};
    const float** f = (const float**)&p;
    for (int i = 0; i < 27; ++i) f[i] = (const float*)d_in[i];
    p.out = (float*)d_out;
    p.ws = (char*)d_ws;
    if (ws_size < WS_END) { fprintf(stderr, "workspace too small: %zu < %zu\n", ws_size, (size_t)WS_END); return; }
#ifndef ONE_LAUNCH
    for (int ph = 0; ph < NPHASE; ++ph) {
        Params q = p;
        q.phase_lo = ph; q.phase_hi = ph;
        int g = phase_items(ph);
        if (g > 2048) g = 2048;
        hipLaunchKernelGGL(fwd_kernel, dim3(g), dim3(256), 0, stream, q);
    }
#else
    static int grid_blocks = 0;
    if (!grid_blocks) {
        int dev = 0, cus = 0, per_cu = 0;
        hipGetDevice(&dev);
        hipDeviceGetAttribute(&cus, hipDeviceAttributeMultiprocessorCount, dev);
        hipOccupancyMaxActiveBlocksPerMultiprocessor(&per_cu, fwd_kernel, 256, 0);
        if (per_cu > 2) per_cu = 2;
        grid_blocks = cus * per_cu;
    }
    p.phase_lo = 0; p.phase_hi = NPHASE - 1;
    hipMemsetAsync((char*)d_ws + OFF_BAR, 0, (size_t)(OFF_CNT - OFF_BAR) + (size_t)3 * 128 * 4, stream);
    void* args[] = {&p};
    hipError_t e = hipLaunchCooperativeKernel((void*)fwd_kernel, dim3(grid_blocks), dim3(256), args, 0, stream);
    if (e != hipSuccess) fprintf(stderr, "cooperative launch failed: %s (grid %d)\n", hipGetErrorString(e), grid_blocks);
#endif
}
```
